# Optimizing an MI355X kernel written in HIP

```python
import jax, jax.numpy as jnp
from jax import lax
import numpy as np

D_MODEL = 1024
BATCH = 2
SEQ = 8192
DEPTH = 2

N_A_LAYERS = DEPTH // 2
N_B_LAYERS = DEPTH - N_A_LAYERS
POOL_WINDOWS = (2, 4, 8, 16)
N_POOL_GROUPS = len(POOL_WINDOWS)
POOL_GROUP = D_MODEL // N_POOL_GROUPS
MAX_POOL = max(POOL_WINDOWS)
HEAD_DIM = 64
N_Q_HEADS = D_MODEL // HEAD_DIM
N_KV_HEADS = 4
Q_PER_KV = N_Q_HEADS // N_KV_HEADS
WINDOW = 128
BLOCK = 128
ROPE_THETA = 10000.0
N_GROUPS = 4
EXPERTS_PER_GROUP = 8
N_EXPERTS = N_GROUPS * EXPERTS_PER_GROUP
TOP_K_IN_GROUP = 2
D_EXPERT = 512
PLE_DIM = 256
EPS = 1e-6

kernel_name = 'yoco_pool_swa_sink_hier_moe_ple'


def rmsnorm(x, g):
    xf = x.astype(jnp.float32)
    y = xf * lax.rsqrt(jnp.mean(xf * xf, axis=-1, keepdims=True) + EPS)
    return (y * g.astype(jnp.float32)).astype(x.dtype)


def rope_tables(positions):
    inv = ROPE_THETA ** (-jnp.arange(0, HEAD_DIM, 2, dtype=jnp.float32) / HEAD_DIM)
    ang = positions.astype(jnp.float32)[..., None] * inv
    return jnp.cos(ang)[:, :, None, :], jnp.sin(ang)[:, :, None, :]


def apply_rope(x, cos, sin):
    xf = x.astype(jnp.float32)
    x1, x2 = jnp.split(xf, 2, axis=-1)
    out = jnp.concatenate([x1 * cos - x2 * sin, x2 * cos + x1 * sin], axis=-1)
    return out.astype(x.dtype)


def pool_mixer(hn, w_pool, scale):
    B, S, D = hn.shape
    xg = hn.reshape(B, S, N_POOL_GROUPS, POOL_GROUP).astype(jnp.float32)
    c = jnp.cumsum(xg, axis=1)
    c = jnp.pad(c, ((0, 0), (MAX_POOL, 0), (0, 0), (0, 0)))
    t = jnp.arange(S)
    means = []
    for gi, w in enumerate(POOL_WINDOWS):
        win_sum = c[:, MAX_POOL:, gi] - c[:, MAX_POOL - w:MAX_POOL - w + S, gi]
        cnt = jnp.minimum(t + 1, w).astype(jnp.float32)
        means.append(win_sum / cnt[None, :, None])
    d = (jnp.stack(means, axis=2) - xg).astype(hn.dtype)
    y = jnp.einsum('bsgc,gce->bsge', d, w_pool).reshape(B, S, D)
    return y * scale


def shared_kv(h, g_kv, w_k, w_v, cos, sin):
    B, S, _ = h.shape
    hn = rmsnorm(h, g_kv)
    k = apply_rope((hn @ w_k).reshape(B, S, N_KV_HEADS, HEAD_DIM), cos, sin)
    v = (hn @ w_v).reshape(B, S, N_KV_HEADS, HEAD_DIM)
    return k, v


def banded_blocks(t, nb):
    B = t.shape[0]
    tp = jnp.pad(t, ((0, 0), (BLOCK, 0), (0, 0), (0, 0)))
    tb = tp.reshape(B, nb + 1, BLOCK, N_KV_HEADS, HEAD_DIM)
    return jnp.concatenate([tb[:, :-1], tb[:, 1:]], axis=2)


def swa_sink_attention(hn, w_q, w_o, sinks, k, v, cos, sin):
    B, S, D = hn.shape
    nb = S // BLOCK
    q = apply_rope((hn @ w_q).reshape(B, S, N_Q_HEADS, HEAD_DIM), cos, sin)
    q = (q * (HEAD_DIM ** -0.5)).reshape(B, nb, BLOCK, N_KV_HEADS, Q_PER_KV, HEAD_DIM)
    kb = banded_blocks(k, nb)
    vb = banded_blocks(v, nb)
    s = jnp.einsum('bnqkgd,bnjkd->bnkgqj', q, kb).astype(jnp.float32)
    i = jnp.arange(BLOCK)[:, None]
    j = jnp.arange(2 * BLOCK)[None, :]
    rel = i + BLOCK - j
    band = (rel >= 0) & (rel < WINDOW)
    valid = (jnp.arange(nb)[:, None, None] > 0) | (j >= BLOCK)[None]
    mask = (band[None] & valid)[None, :, None, None]
    s = jnp.where(mask, s, -jnp.inf)
    sink = sinks.astype(jnp.float32).reshape(1, 1, N_KV_HEADS, Q_PER_KV, 1, 1)
    m = jnp.maximum(jnp.max(s, axis=-1, keepdims=True), sink)
    e = jnp.exp(s - m)
    pr = (e / (jnp.sum(e, axis=-1, keepdims=True) + jnp.exp(sink - m))).astype(vb.dtype)
    o = jnp.einsum('bnkgqj,bnjkd->bnqkgd', pr, vb).reshape(B, S, N_Q_HEADS * HEAD_DIM)
    return o @ w_o


def hierarchical_moe(hn, w_grp, b_grp, w_exp_r, b_exp_r, w_gate, w_up, w_down):
    B, S, D = hn.shape
    T = B * S
    xt = hn.reshape(T, D)
    gl = (xt @ w_grp).astype(jnp.float32) + b_grp.astype(jnp.float32)
    gp = jax.nn.softmax(gl, axis=-1)
    pg, gsel = lax.top_k(gp, 1)
    el = ((xt @ w_exp_r).astype(jnp.float32) + b_exp_r.astype(jnp.float32))
    el = el.reshape(T, N_GROUPS, EXPERTS_PER_GROUP)
    el_sel = jnp.take_along_axis(el, gsel[:, :, None], axis=1)[:, 0]
    top_logit, eidx = lax.top_k(el_sel, TOP_K_IN_GROUP)
    gates = pg * jax.nn.softmax(top_logit, axis=-1)
    expert_id = gsel * EXPERTS_PER_GROUP + eidx
    flat_e = expert_id.reshape(-1)
    flat_tok = jnp.repeat(jnp.arange(T, dtype=jnp.int32), TOP_K_IN_GROUP)
    flat_g = gates.reshape(-1)
    order = jnp.argsort(flat_e)
    stok = flat_tok[order]
    sg = flat_g[order]
    group_sizes = jnp.bincount(flat_e, length=N_EXPERTS).astype(jnp.int32)
    xs = xt[stok]
    a = jax.nn.silu(lax.ragged_dot(xs, w_gate, group_sizes)) * lax.ragged_dot(xs, w_up, group_sizes)
    y = lax.ragged_dot(a, w_down, group_sizes) * sg[:, None].astype(xs.dtype)
    out = jnp.zeros((T, D), y.dtype).at[stok].add(y)
    return out.reshape(B, S, D).astype(hn.dtype)


def per_layer_embedding(h, p_i, g_ple, w_ple_gate, w_ple_up):
    gate = jax.nn.sigmoid(rmsnorm(h, g_ple) @ w_ple_gate)
    return h + gate * (p_i @ w_ple_up)


def setup_inputs(seed: int = 0) -> dict:
    key = jax.random.key(seed)
    ks = jax.random.split(key, 32)
    f32 = jnp.float32

    def nrm(k, shape, scale):
        return jax.random.normal(k, shape, f32) * scale

    D = D_MODEL
    QD = N_Q_HEADS * HEAD_DIM
    KD = N_KV_HEADS * HEAD_DIM
    positions = (jnp.arange(SEQ, dtype=jnp.int32)[None, :]
                 + jax.random.randint(ks[2], (BATCH, 1), 0, 1024, dtype=jnp.int32))
    return {
        'x': nrm(ks[0], (BATCH, SEQ, D), 1.0),
        'p': nrm(ks[1], (DEPTH, BATCH, SEQ, PLE_DIM), 1.0),
        'positions': positions,
        'g_mix': 1.0 + nrm(ks[3], (DEPTH, D), 0.05),
        'g_ffn': 1.0 + nrm(ks[4], (DEPTH, D), 0.05),
        'pool_w': nrm(ks[5], (N_A_LAYERS, N_POOL_GROUPS, POOL_GROUP, POOL_GROUP), POOL_GROUP ** -0.5),
        'pool_scale': 1.0 + nrm(ks[6], (N_A_LAYERS, D), 0.1),
        'g_kv': 1.0 + nrm(ks[7], (D,), 0.05),
        'w_k': nrm(ks[8], (D, KD), D ** -0.5),
        'w_v': nrm(ks[9], (D, KD), D ** -0.5),
        'w_q': nrm(ks[10], (N_B_LAYERS, D, QD), D ** -0.5),
        'w_o': nrm(ks[11], (N_B_LAYERS, QD, D), QD ** -0.5),
        'sinks': nrm(ks[12], (N_B_LAYERS, N_Q_HEADS), 0.5),
        'w_group_router': nrm(ks[13], (DEPTH, D, N_GROUPS), D ** -0.5),
        'b_group_router': nrm(ks[14], (DEPTH, N_GROUPS), 0.01),
        'w_expert_router': nrm(ks[15], (DEPTH, D, N_EXPERTS), D ** -0.5),
        'b_expert_router': nrm(ks[16], (DEPTH, N_EXPERTS), 0.01),
        'w_exp_gate': nrm(ks[17], (DEPTH, N_EXPERTS, D, D_EXPERT), D ** -0.5),
        'w_exp_up': nrm(ks[18], (DEPTH, N_EXPERTS, D, D_EXPERT), D ** -0.5),
        'w_exp_down': nrm(ks[19], (DEPTH, N_EXPERTS, D_EXPERT, D), D_EXPERT ** -0.5),
        'g_ple': 1.0 + nrm(ks[20], (DEPTH, D), 0.05),
        'w_ple_gate': nrm(ks[21], (DEPTH, D, D), D ** -0.5),
        'w_ple_up': nrm(ks[22], (DEPTH, PLE_DIM, D), 0.5 * PLE_DIM ** -0.5),
        'g_final': 1.0 + nrm(ks[23], (D,), 0.05),
    }


def reference(x, p, positions, g_mix, g_ffn, pool_w, pool_scale, g_kv, w_k, w_v, w_q, w_o, sinks,
              w_group_router, b_group_router, w_expert_router, b_expert_router,
              w_exp_gate, w_exp_up, w_exp_down, g_ple, w_ple_gate, w_ple_up, g_final):
    cos, sin = rope_tables(positions)
    h = x
    k_sh = None
    v_sh = None
    for i in range(DEPTH):
        hn = rmsnorm(h, g_mix[i])
        if i < N_A_LAYERS:
            h = h + pool_mixer(hn, pool_w[i], pool_scale[i])
        else:
            jb = i - N_A_LAYERS
            h = h + swa_sink_attention(hn, w_q[jb], w_o[jb], sinks[jb], k_sh, v_sh, cos, sin)
        h = h + hierarchical_moe(rmsnorm(h, g_ffn[i]), w_group_router[i], b_group_router[i],
                                 w_expert_router[i], b_expert_router[i],
                                 w_exp_gate[i], w_exp_up[i], w_exp_down[i])
        h = per_layer_embedding(h, p[i], g_ple[i], w_ple_gate[i], w_ple_up[i])
        if i == N_A_LAYERS - 1:
            k_sh, v_sh = shared_kv(h, g_kv, w_k, w_v, cos, sin)
    return rmsnorm(h, g_final)
```

```cpp
#include <hip/hip_runtime.h>
#include <cstdio>
#include <cstdint>
#include <cstring>

typedef unsigned short bf16_t;
constexpr int T = 16384, D = 1024, SEQ = 8192, NE = 32, DE = 512, PD = 256, HD = 64, NQH = 16, NKVH = 4, KD = 256;
constexpr float EPS = 1e-6f;
constexpr float LOG2E = 1.4426950408889634f;
constexpr float QSCALE = 0.125f * LOG2E;

__device__ __forceinline__ bf16_t f2bf(float f) { unsigned u = __float_as_uint(f); u += 0x7fffu + ((u >> 16) & 1u); return (bf16_t)(u >> 16); }
__device__ __forceinline__ float bf2f(bf16_t b) { return __uint_as_float(((unsigned)b) << 16); }
__device__ __forceinline__ float wave_sum(float v) {
#pragma unroll
    for (int o = 1; o < 64; o <<= 1) v += __shfl_xor(v, o);
    return v;
}

constexpr size_t MiB = 1u << 20;
constexpr size_t WS_CTL = 0;
constexpr size_t WS_CS = 1 * MiB;
constexpr size_t WS_RX = 5 * MiB;
constexpr size_t WS_LIST = 6 * MiB;
constexpr size_t WS_U = 8 * MiB;
constexpr size_t WS_HBA = 72 * MiB;
constexpr size_t WS_HBB = 104 * MiB;
constexpr size_t WS_ACT = 136 * MiB;
constexpr size_t WS_Y = 176 * MiB;
constexpr size_t WS_W = 240 * MiB;
constexpr size_t WS_P16 = WS_ACT;
constexpr size_t WS_D16 = WS_Y;
constexpr size_t WS_Q = WS_Y;
constexpr size_t WS_O = WS_Y + 32 * MiB;
constexpr size_t WS_K = WS_ACT;
constexpr size_t WS_V = WS_ACT + 8 * MiB;
constexpr int CW_CNT = 8192;
constexpr int CW_SS3 = 16384;

struct Ptrs {
    const float *x, *p; const int* pos; const float *g_mix, *g_ffn, *pool_w, *pool_scale, *g_kv, *w_k, *w_v, *w_q, *w_o, *sinks,
        *w_gr, *b_gr, *w_er, *b_er, *w_eg, *w_eu, *w_ed, *g_ple, *w_pg, *w_pu, *g_final;
    float* out; unsigned char* ws;
};

__global__ void k_rms_x(Ptrs P) {
    const int row = blockIdx.x * 4 + (threadIdx.x >> 6), lane = threadIdx.x & 63;
    const float* xr = P.x + (size_t)row * D; float s = 0.f;
    for (int i = lane; i < D; i += 64) s += xr[i] * xr[i];
    s = wave_sum(s);
    if (lane == 0) ((float*)(P.ws + WS_RX))[row] = rsqrtf(s * (1.f / D) + EPS);
}
__global__ void k_cs(Ptrs P) {
    const int i = blockIdx.x * blockDim.x + threadIdx.x; if (i >= T * 32) return;
    const int t = i >> 5, j = i & 31;
    const float inv = powf(10000.f, -(float)(2 * j) / 64.f);
    const float ang = (float)P.pos[t] * inv;
    const double a = (double)ang; const double rev = a * 0.15915494309189535; const double fr = rev - rint(rev);
    const float f = (float)fr * 6.283185307179586f;
    ((float2*)(P.ws + WS_CS))[i] = make_float2(cosf(f), sinf(f));
}
__global__ void k_pooldiff(Ptrs P) {
    const size_t i = (size_t)blockIdx.x * blockDim.x + threadIdx.x; const int t = (int)(i >> 10), c = (int)(i & 1023);
    const int gi = c >> 8, w = 2 << gi, s = t & (SEQ - 1); const int cnt = (s + 1 < w) ? s + 1 : w;
    const float* rx = (const float*)(P.ws + WS_RX); const float g = P.g_mix[c];
    float sum = 0.f;
    for (int j = 0; j < cnt; ++j) sum += P.x[(size_t)(t - j) * D + c] * rx[t - j] * g;
    const float hn = P.x[(size_t)t * D + c] * rx[t] * g;
    ((bf16_t*)(P.ws + WS_D16))[i] = f2bf(sum / (float)cnt - hn);
}
__global__ void k_p16(Ptrs P) {
    const size_t i = (size_t)blockIdx.x * blockDim.x + threadIdx.x; if (i >= (size_t)2 * T * PD) return;
    ((bf16_t*)(P.ws + WS_P16))[i] = f2bf(P.p[i]);
}
template <class F> __global__ void k_ngemm(F f) {
    const int n = blockIdx.x * 256 + threadIdx.x, m0 = blockIdx.y * 8;
    if (!f.begin(m0)) return;
    f.m0 = m0;
    float acc[8], acc2[8];
#pragma unroll
    for (int i = 0; i < 8; ++i) { acc[i] = 0.f; acc2[i] = 0.f; }
    const int K = f.K();
    for (int k = 0; k < K; ++k) {
        float w, w2; f.w(k, n, w, w2);
#pragma unroll
        for (int i = 0; i < 8; ++i) { const float a = f.a(i, k); acc[i] += a * w; acc2[i] += a * w2; }
    }
#pragma unroll
    for (int i = 0; i < 8; ++i) f.epi(i, n, acc[i], acc2[i]);
}
struct FPool {
    Ptrs P; int m0;
    __device__ bool begin(int) { return true; }
    __device__ int K() const { return 256; }
    __device__ void w(int k, int n, float& w, float& w2) const { w = P.pool_w[((size_t)(n >> 8) * 256 + k) * 256 + (n & 255)]; w2 = 0.f; }
    __device__ float a(int i, int k) const { return bf2f(((const bf16_t*)(P.ws + WS_D16))[(size_t)(m0 + i) * D + (blockIdx.x) * 256 + k]); }
    __device__ void epi(int i, int n, float acc, float) const { const int m = m0 + i; P.out[(size_t)m * D + n] = P.x[(size_t)m * D + n] + acc * P.pool_scale[n]; }
};
struct FUp {
    Ptrs P; int l; int m0;
    __device__ bool begin(int) { return true; }
    __device__ int K() const { return PD; }
    __device__ void w(int k, int n, float& w, float& w2) const { w = P.w_pu[((size_t)l * PD + k) * D + n]; w2 = 0.f; }
    __device__ float a(int i, int k) const { return bf2f(((const bf16_t*)(P.ws + WS_P16))[((size_t)l * T + m0 + i) * PD + k]); }
    __device__ void epi(int i, int n, float acc, float) const { ((bf16_t*)(P.ws + WS_U))[((size_t)l * T + m0 + i) * D + n] = f2bf(acc); }
};
__global__ void k_router(Ptrs P, int l, bf16_t* hb) {
    const int t = blockIdx.x * blockDim.x + threadIdx.x; if (t >= T) return;
    const float* h = P.out + (size_t)t * D;
    float lg[36];
#pragma unroll
    for (int j = 0; j < 36; ++j) lg[j] = 0.f;
    float ss = 0.f;
    for (int k = 0; k < D; ++k) {
        const float v = h[k]; ss += v * v; hb[(size_t)t * D + k] = f2bf(v);
        const float hv = v * P.g_ffn[l * D + k];
#pragma unroll
        for (int j = 0; j < 32; ++j) lg[j] += hv * P.w_er[((size_t)l * D + k) * 32 + j];
#pragma unroll
        for (int j = 0; j < 4; ++j) lg[32 + j] += hv * P.w_gr[((size_t)l * D + k) * 4 + j];
    }
    const float r = rsqrtf(ss * (1.f / D) + EPS);
    ((float*)(P.ws + WS_RX))[T + t] = r;
    float gl[4]; int gs = 0; float gm = -1e30f;
#pragma unroll
    for (int j = 0; j < 4; ++j) { gl[j] = lg[32 + j] * r + P.b_gr[l * 4 + j]; if (gl[j] > gm) { gm = gl[j]; gs = j; } }
    float gsum = 0.f;
#pragma unroll
    for (int j = 0; j < 4; ++j) gsum += expf(gl[j] - gm);
    const float pg = 1.f / gsum;
    float el[8];
#pragma unroll
    for (int j = 0; j < 8; ++j) {
        float v = 0.f;
#pragma unroll
        for (int g = 0; g < 4; ++g) v = (g == gs) ? lg[g * 8 + j] : v;
        el[j] = v * r + P.b_er[l * 32 + gs * 8 + j];
    }
    int i0 = 0; float v0 = el[0];
#pragma unroll
    for (int j = 1; j < 8; ++j) if (el[j] > v0) { v0 = el[j]; i0 = j; }
    int i1 = -1; float v1 = -1e30f;
#pragma unroll
    for (int j = 0; j < 8; ++j) if (j != i0 && el[j] > v1) { v1 = el[j]; i1 = j; }
    const float e1 = expf(v1 - v0); const float g0 = pg / (1.f + e1), g1 = pg * e1 / (1.f + e1);
    float* gw = (float*)(P.ws + WS_RX) + 2 * T;
    gw[2 * t] = g0; gw[2 * t + 1] = g1;
    unsigned* cnt = (unsigned*)(P.ws + WS_CTL) + CW_CNT + 64 * l; unsigned* list = (unsigned*)(P.ws + WS_LIST);
    const int ea = gs * 8 + i0, eb = gs * 8 + i1;
    const unsigned pa = atomicAdd(&cnt[ea], 1u); list[(size_t)ea * T + pa] = 2u * t;
    const unsigned pb = atomicAdd(&cnt[eb], 1u); list[(size_t)eb * T + pb] = 2u * t + 1u;
}
__device__ __forceinline__ bool tile_lookup(const unsigned* cnt, int tile, int& e, int& j, int& c) {
    int tb = 0;
    for (int i = 0; i < NE; ++i) { const int ci = (int)cnt[i], nt = (ci + 255) >> 8; if (tile < tb + nt) { e = i; j = tile - tb; c = ci; return true; } tb += nt; }
    return false;
}
struct FGateUp {
    Ptrs P; int l; const bf16_t* hb; int e, j, c; int m0; int en[8];
    __device__ bool begin(int mm) { if (!tile_lookup((const unsigned*)(P.ws + WS_CTL) + CW_CNT + 64 * l, mm >> 8, e, j, c)) return false;
#pragma unroll
        for (int i = 0; i < 8; ++i) en[i] = ent(mm + i);
        return true; }
    __device__ int K() const { return D; }
    __device__ void w(int k, int n, float& w, float& w2) const { const float g = P.g_ffn[l * D + k];
        w = g * P.w_eg[(((size_t)l * NE + e) * D + k) * DE + n]; w2 = g * P.w_eu[(((size_t)l * NE + e) * D + k) * DE + n]; }
    __device__ int ent(int m) const { int idx = j * 256 + (m & 255); if (idx >= c) idx = c - 1; return (int)((const unsigned*)(P.ws + WS_LIST))[(size_t)e * T + idx]; }
    __device__ float a(int i, int k) const { return bf2f(hb[(size_t)(en[i] >> 1) * D + k]); }
    __device__ void epi(int i, int n, float G, float U) const { const int m = m0 + i; const float r = ((const float*)(P.ws + WS_RX))[T + (en[i] >> 1)], gw = ((const float*)(P.ws + WS_RX))[2 * T + en[i]];
        G *= r; U *= r; const float a = gw * (G / (1.f + __expf(-G))) * U; ((bf16_t*)(P.ws + WS_ACT))[(size_t)m * DE + n] = f2bf(a); }
};
struct FDown {
    Ptrs P; int l; int e, j, c; int m0;
    __device__ bool begin(int mm) { return tile_lookup((const unsigned*)(P.ws + WS_CTL) + CW_CNT + 64 * l, mm >> 8, e, j, c); }
    __device__ int K() const { return DE; }
    __device__ void w(int k, int n, float& w, float& w2) const { w = P.w_ed[(((size_t)l * NE + e) * DE + k) * D + n]; w2 = 0.f; }
    __device__ float a(int i, int k) const { return bf2f(((const bf16_t*)(P.ws + WS_ACT))[(size_t)(m0 + i) * DE + k]); }
    __device__ void epi(int i, int n, float acc, float) const { const int m = m0 + i; const int idx = j * 256 + (m & 255); if (idx >= c) return;
        const unsigned en = ((const unsigned*)(P.ws + WS_LIST))[(size_t)e * T + idx]; ((bf16_t*)(P.ws + WS_Y))[(size_t)en * D + n] = f2bf(acc); }
};
__global__ void k_combine(Ptrs P, bf16_t* hbn) {
    const int row = blockIdx.x * 4 + (threadIdx.x >> 6), lane = threadIdx.x & 63;
    float* h = P.out + (size_t)row * D; const bf16_t* y = (const bf16_t*)(P.ws + WS_Y) + (size_t)row * 2 * D;
    float v[16]; float s = 0.f;
#pragma unroll
    for (int i = 0; i < 16; ++i) { const int c = lane + 64 * i; v[i] = h[c] + bf2f(y[c]) + bf2f(y[D + c]); s += v[i] * v[i]; }
    s = wave_sum(s); const float r = rsqrtf(s * (1.f / D) + EPS);
#pragma unroll
    for (int i = 0; i < 16; ++i) { const int c = lane + 64 * i; h[c] = v[i]; hbn[(size_t)row * D + c] = f2bf(v[i] * r); }
}
struct FPle {
    Ptrs P; int l; const bf16_t* hbn; bf16_t* hb3; int m0;
    __device__ bool begin(int) { return true; }
    __device__ int K() const { return D; }
    __device__ void w(int k, int n, float& w, float& w2) const { w = P.g_ple[l * D + k] * P.w_pg[((size_t)l * D + k) * D + n]; w2 = 0.f; }
    __device__ float a(int i, int k) const { return bf2f(hbn[(size_t)(m0 + i) * D + k]); }
    __device__ void epi(int i, int n, float G, float) const { const int m = m0 + i; const float u = bf2f(((const bf16_t*)(P.ws + WS_U))[((size_t)l * T + m) * D + n]);
        const float h = P.out[(size_t)m * D + n] + u / (1.f + __expf(-G)); P.out[(size_t)m * D + n] = h;
        if (hb3) { hb3[(size_t)m * D + n] = f2bf(h); atomicAdd((float*)(P.ws + WS_CTL) + CW_SS3 + m, h * h); } }
};
struct FKvq {
    Ptrs P; const bf16_t* hb3; int m0;
    __device__ bool begin(int) { return true; }
    __device__ int K() const { return D; }
    __device__ void w(int k, int n, float& w, float& w2) const {
        if (n < 256) { const int kh = n >> 6, c = n & 63, d = (c >> 1) + 32 * (c & 1), dp = d ^ 32; const float g = P.g_kv[k]; w = g * P.w_k[(size_t)k * KD + kh * 64 + d]; w2 = g * P.w_k[(size_t)k * KD + kh * 64 + dp]; }
        else if (n < 512) { w = P.g_kv[k] * P.w_v[(size_t)k * KD + (n - 256)]; w2 = 0.f; }
        else { const int q = n - 512, hh = q >> 6, c = q & 63, d = (c >> 1) + 32 * (c & 1), dp = d ^ 32; const float g = P.g_mix[D + k]; w = g * P.w_q[(size_t)k * D + hh * 64 + d]; w2 = g * P.w_q[(size_t)k * D + hh * 64 + dp]; }
    }
    __device__ float a(int i, int k) const { return bf2f(hb3[(size_t)(m0 + i) * D + k]); }
    __device__ void epi(int i, int n, float a1, float a2) const { const int m = m0 + i;
        const float r = rsqrtf(((const float*)(P.ws + WS_CTL))[CW_SS3 + m] * (1.f / D) + EPS); a1 *= r; a2 *= r;
        if (n >= 256 && n < 512) { ((bf16_t*)(P.ws + WS_V))[(size_t)m * KD + (n - 256)] = f2bf(a1); return; }
        const int c = n & 63, pi = c >> 1; const float2 cs = ((const float2*)(P.ws + WS_CS))[(size_t)m * 32 + pi];
        const float o = (c & 1) ? (a1 * cs.x + a2 * cs.y) : (a1 * cs.x - a2 * cs.y);
        if (n < 256) ((bf16_t*)(P.ws + WS_K))[(size_t)m * KD + n] = f2bf(o);
        else ((bf16_t*)(P.ws + WS_Q))[(size_t)m * D + (n - 512)] = f2bf(o * QSCALE);
    }
};
__global__ void __launch_bounds__(64) k_attn(Ptrs P) {
    const int i = blockIdx.x * blockDim.x + threadIdx.x; const int t = i >> 4, h = i & 15, kh = h >> 2, s = t & (SEQ - 1);
    const bf16_t* Q = (const bf16_t*)(P.ws + WS_Q) + (size_t)t * D + h * 64; const bf16_t* Kb = (const bf16_t*)(P.ws + WS_K); const bf16_t* Vb = (const bf16_t*)(P.ws + WS_V);
    float q[64];
#pragma unroll
    for (int d = 0; d < 64; ++d) q[d] = bf2f(Q[d]);
    const int nk = (s + 1 < 128) ? s + 1 : 128; const float sink = P.sinks[h] * LOG2E;
    float m = sink;
    for (int j = 0; j < nk; ++j) { const bf16_t* kr = Kb + (size_t)(t - j) * KD + kh * 64; float sc = 0.f;
#pragma unroll
        for (int d = 0; d < 64; ++d) sc += q[d] * bf2f(kr[d]);
        m = fmaxf(m, sc); }
    float o[64];
#pragma unroll
    for (int d = 0; d < 64; ++d) o[d] = 0.f;
    float den = exp2f(sink - m);
    for (int j = 0; j < nk; ++j) { const bf16_t* kr = Kb + (size_t)(t - j) * KD + kh * 64; const bf16_t* vr = Vb + (size_t)(t - j) * KD + kh * 64; float sc = 0.f;
#pragma unroll
        for (int d = 0; d < 64; ++d) sc += q[d] * bf2f(kr[d]);
        const float e = exp2f(sc - m); den += e;
#pragma unroll
        for (int d = 0; d < 64; ++d) o[d] += e * bf2f(vr[d]); }
    const float inv = 1.f / den; bf16_t* O = (bf16_t*)(P.ws + WS_O) + (size_t)t * D + h * 64;
#pragma unroll
    for (int d = 0; d < 64; ++d) O[d] = f2bf(o[d] * inv);
}
struct FOproj {
    Ptrs P; int m0;
    __device__ bool begin(int) { return true; }
    __device__ int K() const { return D; }
    __device__ void w(int k, int n, float& w, float& w2) const { w = P.w_o[(size_t)k * D + n]; w2 = 0.f; }
    __device__ float a(int i, int k) const { return bf2f(((const bf16_t*)(P.ws + WS_O))[(size_t)(m0 + i) * D + k]); }
    __device__ void epi(int i, int n, float acc, float) const { P.out[(size_t)(m0 + i) * D + n] += acc; }
};
__global__ void k_final(Ptrs P) {
    const int row = blockIdx.x * 4 + (threadIdx.x >> 6), lane = threadIdx.x & 63;
    float* h = P.out + (size_t)row * D; float v[16]; float s = 0.f;
#pragma unroll
    for (int i = 0; i < 16; ++i) { v[i] = h[lane + 64 * i]; s += v[i] * v[i]; }
    s = wave_sum(s); const float r = rsqrtf(s * (1.f / D) + EPS);
#pragma unroll
    for (int i = 0; i < 16; ++i) h[lane + 64 * i] = v[i] * r * P.g_final[lane + 64 * i];
}

extern "C" void kernel_launch(void* const* d_in, const int* in_sizes, int n_in, void* d_out, int out_size, void* d_ws, size_t ws_size, hipStream_t stream) {
    if (n_in != 24 || ws_size < 512 * MiB) { fprintf(stderr, "kernel_launch: unexpected n_in %d / ws %zu\n", n_in, ws_size); return; }
    Ptrs P; memset(&P, 0, sizeof P);
    P.x = (const float*)d_in[0]; P.p = (const float*)d_in[1]; P.pos = (const int*)d_in[2]; P.g_mix = (const float*)d_in[3]; P.g_ffn = (const float*)d_in[4];
    P.pool_w = (const float*)d_in[5]; P.pool_scale = (const float*)d_in[6]; P.g_kv = (const float*)d_in[7]; P.w_k = (const float*)d_in[8]; P.w_v = (const float*)d_in[9];
    P.w_q = (const float*)d_in[10]; P.w_o = (const float*)d_in[11]; P.sinks = (const float*)d_in[12]; P.w_gr = (const float*)d_in[13]; P.b_gr = (const float*)d_in[14];
    P.w_er = (const float*)d_in[15]; P.b_er = (const float*)d_in[16]; P.w_eg = (const float*)d_in[17]; P.w_eu = (const float*)d_in[18]; P.w_ed = (const float*)d_in[19];
    P.g_ple = (const float*)d_in[20]; P.w_pg = (const float*)d_in[21]; P.w_pu = (const float*)d_in[22]; P.g_final = (const float*)d_in[23];
    P.out = (float*)d_out; P.ws = (unsigned char*)d_ws;
    bf16_t* HBA = (bf16_t*)(P.ws + WS_HBA); bf16_t* HBB = (bf16_t*)(P.ws + WS_HBB);
    (void)hipMemsetAsync(P.ws + WS_CTL, 0, 1 * MiB, stream);
    k_rms_x<<<T / 4, 256, 0, stream>>>(P);
    k_cs<<<T * 32 / 256, 256, 0, stream>>>(P);
    k_pooldiff<<<T * D / 256, 256, 0, stream>>>(P);
    k_p16<<<2 * T * PD / 256, 256, 0, stream>>>(P);
    { FPool f; memset(&f, 0, sizeof f); f.P = P; k_ngemm<FPool><<<dim3(4, T / 8), 256, 0, stream>>>(f); }
    for (int l = 0; l < 2; ++l) { FUp f; memset(&f, 0, sizeof f); f.P = P; f.l = l; k_ngemm<FUp><<<dim3(4, T / 8), 256, 0, stream>>>(f); }
    for (int l = 0; l < 2; ++l) {
        k_router<<<T / 64, 64, 0, stream>>>(P, l, HBA);
        { FGateUp f; memset(&f, 0, sizeof f); f.P = P; f.l = l; f.hb = HBA; k_ngemm<FGateUp><<<dim3(2, 160 * 256 / 8), 256, 0, stream>>>(f); }
        { FDown f; memset(&f, 0, sizeof f); f.P = P; f.l = l; k_ngemm<FDown><<<dim3(4, 160 * 256 / 8), 256, 0, stream>>>(f); }
        k_combine<<<T / 4, 256, 0, stream>>>(P, HBB);
        { FPle f; memset(&f, 0, sizeof f); f.P = P; f.l = l; f.hbn = HBB; f.hb3 = (l == 0) ? HBA : nullptr; k_ngemm<FPle><<<dim3(4, T / 8), 256, 0, stream>>>(f); }
        if (l == 0) {
            { FKvq f; memset(&f, 0, sizeof f); f.P = P; f.hb3 = HBA; k_ngemm<FKvq><<<dim3(6, T / 8), 256, 0, stream>>>(f); }
            k_attn<<<T * 16 / 64, 64, 0, stream>>>(P);
            { FOproj f; memset(&f, 0, sizeof f); f.P = P; k_ngemm<FOproj><<<dim3(4, T / 8), 256, 0, stream>>>(f); }
        }
    }
    k_final<<<T / 4, 256, 0, stream>>>(P);
}
```

```cpp
#define HYBRID 0
#define NAIVE_MASK 0u
#include <hip/hip_runtime.h>
#include <cstdio>
#include <cstdint>
#include <cstring>

#define LAS __attribute__((address_space(3)))
typedef unsigned short bf16_t;
typedef short bf16x8 __attribute__((ext_vector_type(8)));
typedef short s16x4 __attribute__((ext_vector_type(4)));
typedef float f32x2 __attribute__((ext_vector_type(2)));
typedef float f32x4 __attribute__((ext_vector_type(4)));
typedef float f32x16 __attribute__((ext_vector_type(16)));
typedef unsigned u32x2 __attribute__((ext_vector_type(2)));
typedef unsigned u32x4 __attribute__((ext_vector_type(4)));

constexpr int T = 16384, D = 1024, SEQ = 8192, NE = 32, DE = 512, PD = 256, HD = 64, NQH = 16, NKVH = 4, KD = 256;
constexpr float EPS = 1e-6f;
constexpr float LOG2E = 1.4426950408889634f;
constexpr float QSCALE = 0.125f * LOG2E;
constexpr int NTHREADS = 512, NWAVES = 8;

__device__ __forceinline__ bf16_t f2bf(float f) { unsigned u = __float_as_uint(f); u += 0x7fffu + ((u >> 16) & 1u); return (bf16_t)(u >> 16); }
__device__ __forceinline__ float bf2f(bf16_t b) { return __uint_as_float(((unsigned)b) << 16); }
__device__ __forceinline__ unsigned cvt_pk_bf16(float lo, float hi) { unsigned r; asm volatile("v_cvt_pk_bf16_f32 %0, %1, %2" : "=v"(r) : "v"(lo), "v"(hi)); return r; }
__device__ __forceinline__ float wave_sum(float v) {
#pragma unroll
    for (int o = 1; o < 64; o <<= 1) v += __shfl_xor(v, o);
    return v;
}
__device__ __forceinline__ float fast_sigmoid(float x) { return __builtin_amdgcn_rcpf(1.f + __builtin_amdgcn_exp2f(-x * LOG2E)); }

constexpr size_t MiB = 1u << 20;
constexpr size_t WS_CTL = 0;
constexpr size_t WS_CS = 1 * MiB;
constexpr size_t WS_RX = 5 * MiB;
constexpr size_t WS_LIST = 6 * MiB;
constexpr size_t WS_U = 8 * MiB;
constexpr size_t WS_HBA = 72 * MiB;
constexpr size_t WS_HBB = 104 * MiB;
constexpr size_t WS_ACT = 136 * MiB;
constexpr size_t WS_Y = 176 * MiB;
constexpr size_t WS_W = 240 * MiB;
constexpr size_t WS_P16 = WS_ACT;
constexpr size_t WS_D16 = WS_Y;
constexpr size_t WS_Q = WS_Y;
constexpr size_t WS_O = WS_Y + 32 * MiB;
constexpr size_t WS_K = WS_ACT;
constexpr size_t WS_V = WS_ACT + 8 * MiB;
constexpr size_t WW_GU = 0;
constexpr size_t WW_DN = 128 * MiB;
constexpr size_t WW_PLEG = 192 * MiB;
constexpr size_t WW_PLEU = 196 * MiB;
constexpr size_t WW_KVQ = 197 * MiB;
constexpr size_t WW_WO = 200 * MiB;
constexpr size_t WW_POOL = 202 * MiB;
constexpr size_t WW_WR = 203 * MiB;
constexpr size_t WS_END = WS_W + 204 * MiB;
constexpr int CW_BAR = 4096;
constexpr int CW_CNT = 8192;
constexpr int CW_SS3 = 16384;

struct Ptrs {
    const float *x, *p; const int* pos; const float *g_mix, *g_ffn, *pool_w, *pool_scale, *g_kv, *w_k, *w_v, *w_q, *w_o, *sinks,
        *w_gr, *b_gr, *w_er, *b_er, *w_eg, *w_eu, *w_ed, *g_ple, *w_pg, *w_pu, *g_final;
    float* out; unsigned char* ws;
};

#define XB_TMO      128
#define XB_XCNT(j)  (256  + 64 * (j))
#define XB_XSUB(j)  (1280 + 64 * (j))
#define XB_XGEN(j)  (2304 + 64 * (j))
#define XB_TOP      3328
#define XB_TOPGEN   3392
#define XCD_BAR_WORDS 3456
#define XB_SPIN_CAP (1u << 18)
__device__ __forceinline__ unsigned xb_ld(unsigned* p)              { return __hip_atomic_load(p, __ATOMIC_RELAXED, __HIP_MEMORY_SCOPE_AGENT); }
__device__ __forceinline__ unsigned xb_add(unsigned* p, unsigned v) { return __hip_atomic_fetch_add(p, v, __ATOMIC_RELAXED, __HIP_MEMORY_SCOPE_AGENT); }
__device__ __forceinline__ unsigned xb_xcc_id() { return (unsigned)__builtin_amdgcn_s_getreg((3 << 11) | 20) & 0xFu; }
#define XB_SPIN(cond, bar) do { unsigned _sp = 0; while (cond) { __builtin_amdgcn_s_sleep(1); \
    if ((++_sp & 255u) == 0u) { if (xb_ld(&(bar)[XB_TMO])) break; if (_sp > XB_SPIN_CAP) { atomicAdd(&(bar)[XB_TMO], 1u); break; } } } } while (0)
struct XcdBarrier { unsigned* bar; unsigned x; volatile LAS unsigned* st; };
__device__ __forceinline__ XcdBarrier xcd_barrier_post(unsigned* bar, volatile LAS unsigned* st) {
    XcdBarrier b; b.bar = bar; b.x = xb_xcc_id(); b.st = st;
    if (threadIdx.x == 0) (void)xb_add(&bar[XB_XCNT(b.x)], 1u);
    return b;
}
__device__ __forceinline__ void xcd_barrier_complete(unsigned* bar, unsigned x, unsigned& nloc, unsigned& nx) {
    const unsigned G = gridDim.x * gridDim.y * gridDim.z;
    unsigned sum, cnt, mine, sp = 0u;
    for (;;) {
        sum = 0u; cnt = 0u; mine = 0u;
#pragma unroll
        for (unsigned j = 0; j < 16; ++j) { const unsigned c = xb_ld(&bar[XB_XCNT(j)]); sum += c; cnt += (c > 0u) ? 1u : 0u; mine = (j == x) ? c : mine; }
        if (sum == G) break;
        __builtin_amdgcn_s_sleep(1);
        if ((++sp & 255u) == 0u) { if (xb_ld(&bar[XB_TMO])) break; if (sp > XB_SPIN_CAP) { atomicAdd(&bar[XB_TMO], 1u); break; } }
    }
    nloc = mine > 0u ? mine : 1u; nx = cnt > 0u ? cnt : 1u;
}
__device__ __forceinline__ void xcd_barrier(const XcdBarrier& b) {
    asm volatile("s_waitcnt vmcnt(0)" ::: "memory");
    __syncthreads();
    if (threadIdx.x == 0) {
        unsigned* bar = b.bar;
        __builtin_amdgcn_s_waitcnt(0);
        unsigned nloc = b.st[0], nx = b.st[1];
        if (nloc == 0u) { xcd_barrier_complete(bar, b.x, nloc, nx); b.st[0] = nloc; b.st[1] = nx; }
        const unsigned old = xb_add(&bar[XB_XSUB(b.x)], 1u);
        const unsigned gen = old / nloc;
        if (old + 1u == (gen + 1u) * nloc) {
            __builtin_amdgcn_fence(__ATOMIC_RELEASE, "agent");
            asm volatile("s_waitcnt vmcnt(0)" ::: "memory");
            const unsigned og = xb_add(&bar[XB_TOP], 1u);
            const unsigned tg = og / nx;
            if (og + 1u == (tg + 1u) * nx) xb_add(&bar[XB_TOPGEN], 1u);
            else XB_SPIN(xb_ld(&bar[XB_TOPGEN]) == tg, bar);
            __builtin_amdgcn_fence(__ATOMIC_ACQUIRE, "agent");
            xb_add(&bar[XB_XGEN(b.x)], 1u);
            asm volatile("s_waitcnt vmcnt(0)" ::: "memory");
        } else {
            XB_SPIN(xb_ld(&bar[XB_XGEN(b.x)]) == gen, bar);
            __builtin_amdgcn_fence(__ATOMIC_ACQUIRE, "agent");
            asm volatile("s_waitcnt vmcnt(0)" ::: "memory");
        }
    }
    __syncthreads();
}

constexpr int RING_BYTES = 131072;
constexpr int MISC_OFF = RING_BYTES;
constexpr int TT_OFF = RING_BYTES + 256;
constexpr int LDS_BYTES = 147456;

namespace g8 {
constexpr int BM = 256, BK = 64, HALF = 128, HTB = HALF * BK * 2, NXCD = 8, WGM = 8;
__device__ __forceinline__ int lds_byte(int r, int c) { const int st = (r >> 4) * 2 + (c >> 5), rr = r & 15, cc = c & 31, ob = rr * 64 + cc * 2; return st * 1024 + (ob ^ (((ob >> 9) & 1) << 5)); }
__device__ __forceinline__ void stage_rc(int b, int& R, int& C) { const int st = b / 1024, sb = b % 1024, swz = sb ^ (((sb >> 9) & 1) << 5); R = (st >> 1) * 16 + swz / 64; C = (st & 1) * 32 + (swz % 64) / 2; }
__device__ __forceinline__ int perm32(int rho) { const int n = rho >> 4, i = rho & 15; return 8 * (i >> 2) + 4 * n + (i & 3); }
__device__ __forceinline__ int xcd_remap(int L, int nwg) { const int q = nwg / NXCD, r = nwg % NXCD, xcd = L % NXCD, off = L / NXCD; return (xcd < r ? xcd * (q + 1) : r * (q + 1) + (xcd - r) * q) + off; }
__device__ __forceinline__ bool dense_unit(int i, int G, int c, int nM, int nN, int& pm, int& pn) {
    const int nwg = nM * nN; const long L = (long)i * G + c; if (L >= nwg) return false;
    const int wgid = xcd_remap((int)L, nwg);
    const int nig = WGM * nN, gid = wgid / nig, fm = gid * WGM, gsz = (nM - fm) < WGM ? (nM - fm) : WGM;
    pm = fm + ((wgid % nig) % gsz); pn = (wgid % nig) / gsz; return true;
}

template <class Job>
__device__ __forceinline__ void gemm_phase(LAS unsigned char* lds, Job& J) {
    typedef typename Job::Unit Unit;
    constexpr int K = Job::K, nt = K / BK;
    static_assert(nt >= 4 && (nt % 2) == 0, "K must be a multiple of 128, >= 256");
    const int tid = threadIdx.x, wid = __builtin_amdgcn_readfirstlane(tid >> 6), lane = tid & 63, wr = wid >> 2, wc = wid & 3, fr = lane & 15, fq = lane >> 4;
    unsigned voffB[2];
#pragma unroll
    for (int i = 0; i < 2; ++i) { int R, C; stage_rc(tid * 16 + i * 8192, R, C); const int Rb = Job::PERM ? ((R & ~31) + perm32(R & 31)) : R; voffB[i] = (unsigned)(Rb * K + C) * 2u; }
    constexpr size_t kstep = (size_t)(BK * 2);
    constexpr size_t hstepB = (size_t)HALF * K * 2;
    const unsigned ldsw = (unsigned)wid * 1024u;
    const int aoff = lds_byte(wr * 64 + fr, fq * 8), boff = lds_byte(wc * 32 + fr, fq * 8);
#define G8_SA(b, h) (((b) * 2 + (h)) * HTB)
#define G8_SB(b, h) ((4 + (b) * 2 + (h)) * HTB)
#define G8_STAGE_B(bufoff, gbase) do { _Pragma("unroll") for (int _i = 0; _i < 2; ++_i) \
        __builtin_amdgcn_global_load_lds((const unsigned*)((const char*)(gbase) + voffB[_i]), (LAS unsigned*)(lds + (bufoff) + ldsw + _i * 8192), 16, 0, 0); } while (0)
#define G8_STAGE_A(bufoff, gbase, off2) do { _Pragma("unroll") for (int _i = 0; _i < 2; ++_i) \
        __builtin_amdgcn_global_load_lds((const unsigned*)((const char*)(gbase) + (off2)[_i]), (LAS unsigned*)(lds + (bufoff) + ldsw + _i * 8192), 16, 0, 0); } while (0)
#define G8_LDA(dst, b, h) do { _Pragma("unroll") for (int m = 0; m < 4; ++m) _Pragma("unroll") for (int k = 0; k < 2; ++k) dst[m][k] = *(const LAS bf16x8*)(lds + G8_SA(b, h) + aoff + m * 2048 + k * 1024); } while (0)
#define G8_LDB(dst, b, h) do { _Pragma("unroll") for (int n = 0; n < 2; ++n) _Pragma("unroll") for (int k = 0; k < 2; ++k) dst[n][k] = *(const LAS bf16x8*)(lds + G8_SB(b, h) + boff + n * 2048 + k * 1024); } while (0)
#define G8_MMA(ai, bj, At, Bt) do { __builtin_amdgcn_s_setprio(1); _Pragma("unroll") for (int m = 0; m < 4; ++m) _Pragma("unroll") for (int n = 0; n < 2; ++n) _Pragma("unroll") for (int k = 0; k < 2; ++k) \
        acc[ai][bj][m][n] = __builtin_amdgcn_mfma_f32_16x16x32_bf16(Bt[n][k], At[m][k], acc[ai][bj][m][n], 0, 0, 0); __builtin_amdgcn_s_setprio(0); } while (0)
#define G8_WAIT_V(n) asm volatile("s_waitcnt vmcnt(" #n ")" ::: "memory")
#define G8_WAIT_L(n) asm volatile("s_waitcnt lgkmcnt(" #n ")" ::: "memory")
#define G8_BAR __builtin_amdgcn_s_barrier()
#define G8_SCHED __builtin_amdgcn_sched_barrier(0)
    Unit cur, nxt; int ui = 0;
    if (!J.next(0, cur)) return;
    unsigned ao[2][2], no[2][2];
    { int tid_ = tid; asm volatile("" : "+v"(tid_)); J.a_offs(cur, tid_, ao); }
    f32x4 acc[2][2][4][2];
#pragma unroll
    for (int a = 0; a < 2; ++a)
#pragma unroll
        for (int b = 0; b < 2; ++b)
#pragma unroll
            for (int m = 0; m < 4; ++m)
#pragma unroll
                for (int n = 0; n < 2; ++n) acc[a][b][m][n] = (f32x4){0.f, 0.f, 0.f, 0.f};
    bf16x8 At[4][2], B0[2][2], B1[2][2];
    const char* cA = J.a_base(cur); const char* cB = J.b_base(cur);
    G8_STAGE_B(G8_SB(0, 0), cB); G8_STAGE_B(G8_SB(0, 1), cB + hstepB); G8_STAGE_A(G8_SA(0, 0), cA, ao[0]); G8_STAGE_A(G8_SA(0, 1), cA, ao[1]);
    if (wr == 1) G8_BAR;
    G8_WAIT_V(2); G8_BAR;
    G8_STAGE_B(G8_SB(1, 0), cB + kstep); G8_STAGE_A(G8_SA(1, 0), cA + kstep, ao[0]); G8_STAGE_B(G8_SB(1, 1), cB + hstepB + kstep);
    G8_WAIT_V(6); G8_BAR;
    for (;;) {
        const bool has_next = J.next(ui + 1, nxt);
        const char* nA = cA; const char* nB = cB;
#pragma unroll
        for (int h = 0; h < 2; ++h)
#pragma unroll
            for (int i = 0; i < 2; ++i) no[h][i] = ao[h][i];
        if (has_next) { nA = J.a_base(nxt); nB = J.b_base(nxt); int tid_ = tid; asm volatile("" : "+v"(tid_)); J.a_offs(nxt, tid_, no); }
#pragma unroll 1
        for (int t = 0; t < nt; t += 2) {
            const bool last = (t == nt - 2);
            const char* a1 = cA + (size_t)(t + 1) * kstep;
            const char* a2 = last ? nA : cA + (size_t)(t + 2) * kstep; const char* b2 = last ? nB : cB + (size_t)(t + 2) * kstep;
            const char* a3 = a2 + kstep; const char* b3 = b2 + kstep;
            unsigned o2[2][2];
#pragma unroll
            for (int h = 0; h < 2; ++h)
#pragma unroll
                for (int i = 0; i < 2; ++i) o2[h][i] = last ? no[h][i] : ao[h][i];
            G8_LDB(B0, 0, 0); G8_LDB(B1, 0, 1); G8_SCHED; G8_LDA(At, 0, 0); G8_STAGE_A(G8_SA(1, 1), a1, ao[1]);
            G8_WAIT_V(8); G8_WAIT_L(0); G8_BAR; G8_MMA(0, 0, At, B0); G8_MMA(0, 1, At, B1); G8_BAR; G8_SCHED;
            G8_LDA(At, 0, 1); G8_STAGE_B(G8_SB(0, 0), b2); G8_STAGE_B(G8_SB(0, 1), b2 + hstepB); G8_STAGE_A(G8_SA(0, 0), a2, o2[0]);
            G8_WAIT_V(8); G8_WAIT_L(0); G8_BAR; G8_MMA(1, 0, At, B0); G8_MMA(1, 1, At, B1); G8_BAR; G8_SCHED;
            G8_LDB(B0, 1, 0); G8_LDB(B1, 1, 1); G8_SCHED; G8_LDA(At, 1, 0); G8_STAGE_A(G8_SA(0, 1), a2, o2[1]);
            G8_WAIT_V(8); G8_WAIT_L(0); G8_BAR; G8_MMA(0, 0, At, B0); G8_MMA(0, 1, At, B1); G8_BAR; G8_SCHED;
            G8_LDA(At, 1, 1); G8_STAGE_B(G8_SB(1, 0), b3); G8_STAGE_B(G8_SB(1, 1), b3 + hstepB); G8_STAGE_A(G8_SA(1, 0), a3, o2[0]);
            G8_WAIT_V(8); G8_WAIT_L(0); G8_BAR; G8_MMA(1, 0, At, B0); G8_MMA(1, 1, At, B1); G8_BAR; G8_SCHED;
        }
        if (wr == 0) G8_BAR;
        { int fr_ = fr, fq_ = fq; asm volatile("" : "+v"(fr_), "+v"(fq_)); J.epi(acc, cur, wr, wc, fr_, fq_); }
        if (!has_next) break;
#pragma unroll
        for (int a = 0; a < 2; ++a)
#pragma unroll
            for (int b = 0; b < 2; ++b)
#pragma unroll
                for (int m = 0; m < 4; ++m)
#pragma unroll
                    for (int n = 0; n < 2; ++n) acc[a][b][m][n] = (f32x4){0.f, 0.f, 0.f, 0.f};
        cur = nxt; cA = nA; cB = nB; ++ui;
#pragma unroll
        for (int h = 0; h < 2; ++h)
#pragma unroll
            for (int i = 0; i < 2; ++i) ao[h][i] = no[h][i];
        if (wr == 1) G8_BAR;
    }
    G8_WAIT_V(0);
    G8_BAR;
#undef G8_SA
#undef G8_SB
#undef G8_STAGE_A
#undef G8_STAGE_B
#undef G8_LDA
#undef G8_LDB
#undef G8_MMA
#undef G8_WAIT_V
#undef G8_WAIT_L
#undef G8_BAR
#undef G8_SCHED
}
}
struct JobBase { Ptrs P; int G, c; };

__device__ __forceinline__ void dense_offs(int lda, int tid, unsigned (&o)[2][2]) {
#pragma unroll
    for (int i = 0; i < 2; ++i) { int R, C; g8::stage_rc(tid * 16 + i * 8192, R, C);
#pragma unroll
        for (int h = 0; h < 2; ++h) o[h][i] = (unsigned)((h * 128 + R) * lda + C) * 2u; }
}

struct JobPool : JobBase {
    static constexpr int K = 256; static constexpr bool PERM = false;
    struct Unit { int pm, pn; };
    __device__ __forceinline__ bool next(int i, Unit& u) const { return g8::dense_unit(i, G, c, T / 256, 4, u.pm, u.pn); }
    __device__ __forceinline__ const char* a_base(const Unit& u) const { return (const char*)(P.ws + WS_D16) + ((size_t)u.pm * 256 * D + u.pn * 256) * 2; }
    __device__ __forceinline__ const char* b_base(const Unit& u) const { return (const char*)(P.ws + WS_W + WW_POOL) + (size_t)u.pn * 256 * 256 * 2; }
    __device__ __forceinline__ void a_offs(const Unit&, int tid, unsigned (&o)[2][2]) const { dense_offs(D, tid, o); }
    __device__ __forceinline__ void epi(const f32x4 (&acc)[2][2][4][2], const Unit& u, int wr, int wc, int fr, int fq) const {
        const int row0 = u.pm * 256 + wr * 64 + fr, col0 = u.pn * 256 + wc * 32 + 4 * fq;
#pragma unroll
        for (int ai = 0; ai < 2; ++ai)
#pragma unroll
            for (int m = 0; m < 4; ++m) { const size_t ro = (size_t)(row0 + ai * 128 + m * 16) * D + col0;
#pragma unroll
                for (int bj = 0; bj < 2; ++bj)
#pragma unroll
                    for (int n = 0; n < 2; ++n) { const f32x4 xv = *(const f32x4*)(P.x + ro + bj * 128 + n * 16); *(f32x4*)(P.out + ro + bj * 128 + n * 16) = xv + acc[ai][bj][m][n]; } }
    }
};
struct JobUp : JobBase {
    static constexpr int K = 256; static constexpr bool PERM = true;
    struct Unit { int l, pm, pn; };
    __device__ __forceinline__ bool next(int i, Unit& u) const { int pm2; if (!g8::dense_unit(i, G, c, 2 * T / 256, 4, pm2, u.pn)) return false; u.l = pm2 >> 6; u.pm = pm2 & 63; return true; }
    __device__ __forceinline__ const char* a_base(const Unit& u) const { return (const char*)(P.ws + WS_P16) + ((size_t)u.l * T + (size_t)u.pm * 256) * PD * 2; }
    __device__ __forceinline__ const char* b_base(const Unit& u) const { return (const char*)(P.ws + WS_W + WW_PLEU) + ((size_t)u.l * D + (size_t)u.pn * 256) * PD * 2; }
    __device__ __forceinline__ void a_offs(const Unit&, int tid, unsigned (&o)[2][2]) const { dense_offs(PD, tid, o); }
    __device__ __forceinline__ void epi(const f32x4 (&acc)[2][2][4][2], const Unit& u, int wr, int wc, int fr, int fq) const {
        bf16_t* Ub = (bf16_t*)(P.ws + WS_U) + (size_t)u.l * T * D;
        const int row0 = u.pm * 256 + wr * 64 + fr, col0 = u.pn * 256 + wc * 32 + 8 * fq;
#pragma unroll
        for (int ai = 0; ai < 2; ++ai)
#pragma unroll
            for (int m = 0; m < 4; ++m) { bf16_t* rowp = Ub + (size_t)(row0 + ai * 128 + m * 16) * D + col0;
#pragma unroll
                for (int bj = 0; bj < 2; ++bj) { const f32x4 v0 = acc[ai][bj][m][0], v1 = acc[ai][bj][m][1];
                    u32x4 w; w.x = cvt_pk_bf16(v0[0], v0[1]); w.y = cvt_pk_bf16(v0[2], v0[3]); w.z = cvt_pk_bf16(v1[0], v1[1]); w.w = cvt_pk_bf16(v1[2], v1[3]);
                    *(u32x4*)(rowp + bj * 128) = w; } }
    }
};
__device__ __forceinline__ void build_tile_table(const Ptrs& P, int l, LAS int* tt) {
    const unsigned* cnt = (const unsigned*)(P.ws + WS_CTL) + CW_CNT + 64 * l;
    const int t = threadIdx.x;
    if (t < 161) {
        int tb = 0, lb = -1, nv = 0;
        for (int e = 0; e < NE; ++e) { const int ce = (int)cnt[e], ntl = (ce + 255) >> 8;
            if (t < 160 && t >= tb && t < tb + ntl) { const int j = t - tb; lb = e * T + 256 * j; nv = ce - 256 * j; if (nv > 256) nv = 256; }
            tb += ntl; }
        if (t == 160) tt[0] = tb; else { tt[1 + 2 * t] = lb; tt[2 + 2 * t] = nv; }
    }
    __syncthreads();
}
struct MoeUnit { int tile, pn, lb, nv; };
__device__ __forceinline__ bool moe_unit(int i, int G, int c, const LAS int* tt, MoeUnit& u) {
    const int ntiles = __builtin_amdgcn_readfirstlane(tt[0]); const int nwg = ntiles * 4;
    const long L = (long)i * G + c; if (L >= nwg) return false;
    const int v = g8::xcd_remap((int)L, nwg);
    u.tile = v >> 2; u.pn = v & 3; u.lb = __builtin_amdgcn_readfirstlane(tt[1 + 2 * u.tile]); u.nv = __builtin_amdgcn_readfirstlane(tt[2 + 2 * u.tile]); return true;
}
struct JobGateUp : JobBase {
    static constexpr int K = 1024; static constexpr bool PERM = true;
    typedef MoeUnit Unit;
    int l; const bf16_t* hb; const LAS int* tt;
    __device__ __forceinline__ bool next(int i, Unit& u) const { return moe_unit(i, G, c, tt, u); }
    __device__ __forceinline__ const char* a_base(const Unit&) const { return (const char*)hb; }
    __device__ __forceinline__ const char* b_base(const Unit& u) const { const int e = u.lb >> 14; return (const char*)(P.ws + WS_W + WW_GU) + (((size_t)l * NE + e) * 1024 + (size_t)u.pn * 256) * 1024 * 2; }
    __device__ __forceinline__ void a_offs(const Unit& u, int tid, unsigned (&o)[2][2]) const {
        const unsigned* list = (const unsigned*)(P.ws + WS_LIST) + u.lb;
#pragma unroll
        for (int i = 0; i < 2; ++i) { int R, C; g8::stage_rc(tid * 16 + i * 8192, R, C);
#pragma unroll
            for (int h = 0; h < 2; ++h) { int rt = h * 128 + R; rt = rt < u.nv ? rt : u.nv - 1; const unsigned en = list[rt]; o[h][i] = (en >> 1) * (unsigned)(D * 2) + (unsigned)C * 2u; } }
    }
    __device__ __forceinline__ void epi(const f32x4 (&acc)[2][2][4][2], const Unit& u, int wr, int wc, int fr, int fq) const {
        const unsigned* list = (const unsigned*)(P.ws + WS_LIST) + u.lb; const float* rr = (const float*)(P.ws + WS_RX) + T; const float* gwv = (const float*)(P.ws + WS_RX) + 2 * T;
        bf16_t* act = (bf16_t*)(P.ws + WS_ACT) + (size_t)u.tile * 256 * DE + u.pn * 128 + wc * 32 + 8 * fq;
#pragma unroll
        for (int ai = 0; ai < 2; ++ai)
#pragma unroll
            for (int m = 0; m < 4; ++m) { const int rt = ai * 128 + wr * 64 + m * 16 + fr; const int rc = rt < u.nv ? rt : u.nv - 1; const unsigned en = list[rc];
                const float r = rr[en >> 1], gw = gwv[en];
                float o[8];
#pragma unroll
                for (int n = 0; n < 2; ++n)
#pragma unroll
                    for (int j = 0; j < 4; ++j) { const float g = acc[ai][0][m][n][j] * r, up = acc[ai][1][m][n][j] * r; o[n * 4 + j] = gw * g * fast_sigmoid(g) * up; }
                u32x4 w; w.x = cvt_pk_bf16(o[0], o[1]); w.y = cvt_pk_bf16(o[2], o[3]); w.z = cvt_pk_bf16(o[4], o[5]); w.w = cvt_pk_bf16(o[6], o[7]);
                *(u32x4*)(act + (size_t)rt * DE) = w; }
    }
};
struct JobDown : JobBase {
    static constexpr int K = 512; static constexpr bool PERM = true;
    typedef MoeUnit Unit;
    int l; const LAS int* tt;
    __device__ __forceinline__ bool next(int i, Unit& u) const { return moe_unit(i, G, c, tt, u); }
    __device__ __forceinline__ const char* a_base(const Unit& u) const { return (const char*)(P.ws + WS_ACT) + (size_t)u.tile * 256 * DE * 2; }
    __device__ __forceinline__ const char* b_base(const Unit& u) const { const int e = u.lb >> 14; return (const char*)(P.ws + WS_W + WW_DN) + (((size_t)l * NE + e) * 1024 + (size_t)u.pn * 256) * DE * 2; }
    __device__ __forceinline__ void a_offs(const Unit&, int tid, unsigned (&o)[2][2]) const { dense_offs(DE, tid, o); }
    __device__ __forceinline__ void epi(const f32x4 (&acc)[2][2][4][2], const Unit& u, int wr, int wc, int fr, int fq) const {
        const unsigned* list = (const unsigned*)(P.ws + WS_LIST) + u.lb;
        bf16_t* Y = (bf16_t*)(P.ws + WS_Y) + u.pn * 256 + wc * 32 + 8 * fq;
#pragma unroll
        for (int ai = 0; ai < 2; ++ai)
#pragma unroll
            for (int m = 0; m < 4; ++m) { const int rt = ai * 128 + wr * 64 + m * 16 + fr;
                if (rt < u.nv) { const unsigned en = list[rt]; bf16_t* rowp = Y + (size_t)en * D;
#pragma unroll
                    for (int bj = 0; bj < 2; ++bj) { const f32x4 v0 = acc[ai][bj][m][0], v1 = acc[ai][bj][m][1];
                        u32x4 w; w.x = cvt_pk_bf16(v0[0], v0[1]); w.y = cvt_pk_bf16(v0[2], v0[3]); w.z = cvt_pk_bf16(v1[0], v1[1]); w.w = cvt_pk_bf16(v1[2], v1[3]);
                        *(u32x4*)(rowp + bj * 128) = w; } } }
    }
};
struct JobPle : JobBase {
    static constexpr int K = 1024; static constexpr bool PERM = false;
    struct Unit { int pm, pn; };
    int l; const bf16_t* hbn; bf16_t* hb3;
    __device__ __forceinline__ bool next(int i, Unit& u) const { return g8::dense_unit(i, G, c, T / 256, 4, u.pm, u.pn); }
    __device__ __forceinline__ const char* a_base(const Unit& u) const { return (const char*)hbn + (size_t)u.pm * 256 * D * 2; }
    __device__ __forceinline__ const char* b_base(const Unit& u) const { return (const char*)(P.ws + WS_W + WW_PLEG) + ((size_t)l * D + (size_t)u.pn * 256) * D * 2; }
    __device__ __forceinline__ void a_offs(const Unit&, int tid, unsigned (&o)[2][2]) const { dense_offs(D, tid, o); }
    __device__ __forceinline__ void epi(const f32x4 (&acc)[2][2][4][2], const Unit& u, int wr, int wc, int fr, int fq) const {
        const bf16_t* Ub = (const bf16_t*)(P.ws + WS_U) + (size_t)l * T * D; float* ss3 = (float*)(P.ws + WS_CTL) + CW_SS3;
        const int row0 = u.pm * 256 + wr * 64 + fr, col0 = u.pn * 256 + wc * 32 + 4 * fq;
#pragma unroll
        for (int ai = 0; ai < 2; ++ai)
#pragma unroll
            for (int m = 0; m < 4; ++m) { const int row = row0 + ai * 128 + m * 16; const size_t ro = (size_t)row * D + col0; float ss = 0.f;
#pragma unroll
                for (int bj = 0; bj < 2; ++bj)
#pragma unroll
                    for (int n = 0; n < 2; ++n) { const size_t o = ro + bj * 128 + n * 16; const f32x4 hv = *(const f32x4*)(P.out + o); const u32x2 uu = *(const u32x2*)(Ub + o);
                        const f32x4 g = acc[ai][bj][m][n]; f32x4 hn;
                        hn[0] = hv[0] + fast_sigmoid(g[0]) * __uint_as_float(uu.x << 16); hn[1] = hv[1] + fast_sigmoid(g[1]) * __uint_as_float(uu.x & 0xffff0000u);
                        hn[2] = hv[2] + fast_sigmoid(g[2]) * __uint_as_float(uu.y << 16); hn[3] = hv[3] + fast_sigmoid(g[3]) * __uint_as_float(uu.y & 0xffff0000u);
                        *(f32x4*)(P.out + o) = hn;
                        if (hb3) { u32x2 w; w.x = cvt_pk_bf16(hn[0], hn[1]); w.y = cvt_pk_bf16(hn[2], hn[3]); *(u32x2*)(hb3 + o) = w; ss += (hn[0] * hn[0] + hn[1] * hn[1]) + (hn[2] * hn[2] + hn[3] * hn[3]); } }
                if (hb3) { ss += __shfl_xor(ss, 16); ss += __shfl_xor(ss, 32); if (fq == 0) atomicAdd(ss3 + row, ss); } }
    }
};
struct JobKvq : JobBase {
    static constexpr int K = 1024; static constexpr bool PERM = true;
    struct Unit { int pm, pn; };
    const bf16_t* hb3;
    __device__ __forceinline__ bool next(int i, Unit& u) const { return g8::dense_unit(i, G, c, T / 256, 6, u.pm, u.pn); }
    __device__ __forceinline__ const char* a_base(const Unit& u) const { return (const char*)hb3 + (size_t)u.pm * 256 * D * 2; }
    __device__ __forceinline__ const char* b_base(const Unit& u) const { return (const char*)(P.ws + WS_W + WW_KVQ) + (size_t)u.pn * 256 * D * 2; }
    __device__ __forceinline__ void a_offs(const Unit&, int tid, unsigned (&o)[2][2]) const { dense_offs(D, tid, o); }
    __device__ __forceinline__ void epi(const f32x4 (&acc)[2][2][4][2], const Unit& u, int wr, int wc, int fr, int fq) const {
        const float* ss3 = (const float*)(P.ws + WS_CTL) + CW_SS3; const float* cs = (const float*)(P.ws + WS_CS);
        const int row0 = u.pm * 256 + wr * 64 + fr, cw = wc * 32 + 8 * fq;
        bf16_t* dst; int ldd; float sc = 1.f;
        if (u.pn == 0) { dst = (bf16_t*)(P.ws + WS_K); ldd = KD; } else if (u.pn == 1) { dst = (bf16_t*)(P.ws + WS_V); ldd = KD; } else { dst = (bf16_t*)(P.ws + WS_Q) + (u.pn - 2) * 256; ldd = D; sc = QSCALE; }
        const bool rope = (u.pn != 1);
#pragma unroll
        for (int ai = 0; ai < 2; ++ai)
#pragma unroll
            for (int m = 0; m < 4; ++m) { const int row = row0 + ai * 128 + m * 16; const float r = __builtin_amdgcn_rsqf(ss3[row] * (1.f / D) + EPS) * sc;
#pragma unroll
                for (int bj = 0; bj < 2; ++bj) { f32x4 v0 = acc[ai][bj][m][0] * r, v1 = acc[ai][bj][m][1] * r; const int cc = bj * 128 + cw;
                    if (rope) { const int pi = (cc & 63) >> 1; const f32x4 c0 = *(const f32x4*)(cs + (size_t)row * 64 + pi * 2), c1 = *(const f32x4*)(cs + (size_t)row * 64 + pi * 2 + 4);
                        f32x4 w0, w1;
                        w0[0] = v0[0] * c0[0] - v0[1] * c0[1]; w0[1] = v0[1] * c0[0] + v0[0] * c0[1]; w0[2] = v0[2] * c0[2] - v0[3] * c0[3]; w0[3] = v0[3] * c0[2] + v0[2] * c0[3];
                        w1[0] = v1[0] * c1[0] - v1[1] * c1[1]; w1[1] = v1[1] * c1[0] + v1[0] * c1[1]; w1[2] = v1[2] * c1[2] - v1[3] * c1[3]; w1[3] = v1[3] * c1[2] + v1[2] * c1[3];
                        v0 = w0; v1 = w1; }
                    u32x4 w; w.x = cvt_pk_bf16(v0[0], v0[1]); w.y = cvt_pk_bf16(v0[2], v0[3]); w.z = cvt_pk_bf16(v1[0], v1[1]); w.w = cvt_pk_bf16(v1[2], v1[3]);
                    *(u32x4*)(dst + (size_t)row * ldd + cc) = w; } }
    }
};
struct JobOproj : JobBase {
    static constexpr int K = 1024; static constexpr bool PERM = false;
    struct Unit { int pm, pn; };
    __device__ __forceinline__ bool next(int i, Unit& u) const { return g8::dense_unit(i, G, c, T / 256, 4, u.pm, u.pn); }
    __device__ __forceinline__ const char* a_base(const Unit& u) const { return (const char*)(P.ws + WS_O) + (size_t)u.pm * 256 * D * 2; }
    __device__ __forceinline__ const char* b_base(const Unit& u) const { return (const char*)(P.ws + WS_W + WW_WO) + (size_t)u.pn * 256 * D * 2; }
    __device__ __forceinline__ void a_offs(const Unit&, int tid, unsigned (&o)[2][2]) const { dense_offs(D, tid, o); }
    __device__ __forceinline__ void epi(const f32x4 (&acc)[2][2][4][2], const Unit& u, int wr, int wc, int fr, int fq) const {
        const int row0 = u.pm * 256 + wr * 64 + fr, col0 = u.pn * 256 + wc * 32 + 4 * fq;
#pragma unroll
        for (int ai = 0; ai < 2; ++ai)
#pragma unroll
            for (int m = 0; m < 4; ++m) { const size_t ro = (size_t)(row0 + ai * 128 + m * 16) * D + col0;
#pragma unroll
                for (int bj = 0; bj < 2; ++bj)
#pragma unroll
                    for (int n = 0; n < 2; ++n) { float* p = P.out + ro + bj * 128 + n * 16; *(f32x4*)p = *(const f32x4*)p + acc[ai][bj][m][n]; } }
    }
};
__device__ __forceinline__ int tr_row(int mode, int roff, int n) {
    if (mode == 1) return roff + (n & ~63) + 2 * (n & 31) + ((n >> 5) & 1);
    if (mode == 2) return roff + (n >> 7) * 256 + (n & 127);
    return roff + n;
}
__device__ __forceinline__ void tr_item(const float* W, int N, const float* ksc, const float* nsc, bf16_t* WT, int ldk, int mode, int roff, int k0, int n0, LAS float* scr, int lane) {
#pragma unroll 8
    for (int i = 0; i < 32; ++i) { const int kk = 2 * i + (lane >> 5); float v = W[(size_t)(k0 + kk) * N + n0 + (lane & 31)]; if (ksc) v *= ksc[k0 + kk]; scr[kk * 33 + (lane & 31)] = v; }
    asm volatile("s_waitcnt lgkmcnt(0)" ::: "memory");
    const int c = lane & 7;
#pragma unroll
    for (int j = 0; j < 4; ++j) { const int n = (lane >> 3) + 8 * j; const LAS float* s = scr + (8 * c) * 33 + n; const float ns = nsc ? nsc[n0 + n] : 1.f;
        u32x4 o; o.x = cvt_pk_bf16(s[0 * 33] * ns, s[1 * 33] * ns); o.y = cvt_pk_bf16(s[2 * 33] * ns, s[3 * 33] * ns); o.z = cvt_pk_bf16(s[4 * 33] * ns, s[5 * 33] * ns); o.w = cvt_pk_bf16(s[6 * 33] * ns, s[7 * 33] * ns);
        *(u32x4*)(WT + (size_t)tr_row(mode, roff, n0 + n) * ldk + k0 + 8 * c) = o; }
    asm volatile("s_waitcnt lgkmcnt(0)" ::: "memory");
}
constexpr int N_TR_EXP = 64 * 768, N_TR_SMALL = 2688, N_TR_ITEMS = N_TR_EXP + N_TR_SMALL;
__device__ __forceinline__ void tr_dispatch(const Ptrs& P, int it, LAS float* scr, int lane) {
    bf16_t* Wb = (bf16_t*)(P.ws + WS_W);
    if (it < N_TR_EXP) {
        const int le = it / 768, r = it % 768, which = r >> 8, r2 = r & 255, l = le >> 5;
        if (which < 2) { const float* src = (which ? P.w_eu : P.w_eg) + (size_t)le * D * DE;
            tr_item(src, DE, P.g_ffn + l * D, nullptr, Wb + WW_GU / 2 + (size_t)le * 1024 * 1024, 1024, 2, which * 128, (r2 >> 4) * 64, (r2 & 15) * 32, scr, lane); }
        else tr_item(P.w_ed + (size_t)le * DE * D, D, nullptr, nullptr, Wb + WW_DN / 2 + (size_t)le * 1024 * DE, DE, 0, 0, (r2 >> 5) * 64, (r2 & 31) * 32, scr, lane);
        return;
    }
    int s = it - N_TR_EXP;
    if (s < 1024) { const int l = s >> 9, r = s & 511; tr_item(P.w_pg + (size_t)l * D * D, D, P.g_ple + l * D, nullptr, Wb + WW_PLEG / 2 + (size_t)l * D * D, D, 0, 0, (r >> 5) * 64, (r & 31) * 32, scr, lane); return; }
    s -= 1024;
    if (s < 256) { const int l = s >> 7, r = s & 127; tr_item(P.w_pu + (size_t)l * PD * D, D, nullptr, nullptr, Wb + WW_PLEU / 2 + (size_t)l * D * PD, PD, 0, 0, (r >> 5) * 64, (r & 31) * 32, scr, lane); return; }
    s -= 256;
    if (s < 128) { tr_item(P.w_k, KD, P.g_kv, nullptr, Wb + WW_KVQ / 2, D, 1, 0, (s >> 3) * 64, (s & 7) * 32, scr, lane); return; }
    s -= 128;
    if (s < 128) { tr_item(P.w_v, KD, P.g_kv, nullptr, Wb + WW_KVQ / 2, D, 0, 256, (s >> 3) * 64, (s & 7) * 32, scr, lane); return; }
    s -= 128;
    if (s < 512) { tr_item(P.w_q, D, P.g_mix + D, nullptr, Wb + WW_KVQ / 2, D, 1, 512, (s >> 5) * 64, (s & 31) * 32, scr, lane); return; }
    s -= 512;
    if (s < 512) { tr_item(P.w_o, D, nullptr, nullptr, Wb + WW_WO / 2, D, 0, 0, (s >> 5) * 64, (s & 31) * 32, scr, lane); return; }
    s -= 512;
    { const int g = s >> 5, r = s & 31; tr_item(P.pool_w + (size_t)g * 65536, 256, nullptr, P.pool_scale + g * 256, Wb + WW_POOL / 2 + (size_t)g * 65536, 256, 0, 0, (r >> 3) * 64, (r & 7) * 32, scr, lane); }
}
template <int W> __device__ __forceinline__ void pooldiff_cols(const Ptrs& P, int t0, int s0, const LAS float* rr, int c) {
    const float2 g = *(const float2*)(P.g_mix + c);
    float2 ring[16];
#pragma unroll
    for (int i = 0; i < 16; ++i) ring[i] = make_float2(0.f, 0.f);
    bf16_t* dout = (bf16_t*)(P.ws + WS_D16);
    for (int blk = 0; blk < 5; ++blk) {
#pragma unroll
        for (int jj = 0; jj < 16; ++jj) {
            const int j = blk * 16 + jj - 16;
            const int s = s0 + j;
            float2 v = make_float2(0.f, 0.f);
            if (s >= 0) { const float2 xv = *(const float2*)(P.x + (size_t)(t0 + j) * D + c); const float r = rr[j + 16]; v.x = xv.x * r * g.x; v.y = xv.y * r * g.y; }
            ring[jj] = v;
            if (j >= 0) {
                float2 sum = make_float2(0.f, 0.f);
#pragma unroll
                for (int q = 0; q < W; ++q) { const float2 e = ring[(jj - q) & 15]; sum.x += e.x; sum.y += e.y; }
                const int cnt = (s + 1 < W) ? s + 1 : W; const float ic = 1.f / (float)cnt;
                *(unsigned*)(dout + (size_t)(t0 + j) * D + c) = cvt_pk_bf16(sum.x * ic - v.x, sum.y * ic - v.y);
            }
        }
    }
}
__device__ __forceinline__ void phase_prologue(const Ptrs& P, LAS unsigned char* lds, int vcu, int G) {
    const int tid = threadIdx.x, lane = tid & 63, wave = tid >> 6;
    const int gw = vcu * NWAVES + wave, NGW = G * NWAVES;
    LAS float* scr = (LAS float*)(lds + wave * 16384);
    for (int it = gw; it < N_TR_ITEMS; it += NGW) tr_dispatch(P, it, scr, lane);
    const size_t gt = (size_t)blockIdx.x * NTHREADS + tid, GT = (size_t)G * NTHREADS;
    { float* wr = (float*)(P.ws + WS_W + WW_WR);
      for (size_t i = gt; i < (size_t)2 * 48 * D; i += GT) { const int k = (int)(i & 1023), n = (int)((i >> 10) % 48), l = (int)(i / (48 * 1024));
          float v = 0.f; if (n < 32) v = P.w_er[((size_t)l * D + k) * 32 + n]; else if (n < 36) v = P.w_gr[((size_t)l * D + k) * 4 + (n - 32)];
          wr[i] = v * P.g_ffn[l * D + k]; } }
    { float2* cs = (float2*)(P.ws + WS_CS);
      for (size_t i = gt; i < (size_t)T * 32; i += GT) { const int t = (int)(i >> 5), j = (int)(i & 31);
          const float inv = exp2f(-(float)j * (13.287712379549449f / 32.f));
          const float ang = (float)P.pos[t] * inv; const double rev = (double)ang * 0.15915494309189535; const float fr = (float)(rev - rint(rev));
          cs[i] = make_float2(__builtin_amdgcn_cosf(fr), __builtin_amdgcn_sinf(fr)); } }
    { bf16_t* p16 = (bf16_t*)(P.ws + WS_P16);
      for (size_t i = gt; i < (size_t)2 * T * PD / 4; i += GT) { const f32x4 v = *(const f32x4*)(P.p + 4 * i); u32x2 w; w.x = cvt_pk_bf16(v[0], v[1]); w.y = cvt_pk_bf16(v[2], v[3]); *(u32x2*)(p16 + 4 * i) = w; } }
    __syncthreads();
    LAS float* rr = (LAS float*)lds;
    for (int ch = blockIdx.x; ch < T / 64; ch += G) {
        const int t0 = ch * 64, s0 = t0 & (SEQ - 1);
        for (int j = wave; j < 80; j += NWAVES) { const int s = s0 + j - 16; float r = 0.f;
            if (s >= 0) { const f32x4* xr = (const f32x4*)(P.x + (size_t)(t0 + j - 16) * D) + lane; float a = 0.f;
#pragma unroll
                for (int q = 0; q < 4; ++q) { const f32x4 v = xr[64 * q]; a += (v[0] * v[0] + v[1] * v[1]) + (v[2] * v[2] + v[3] * v[3]); }
                r = __builtin_amdgcn_rsqf(wave_sum(a) * (1.f / D) + EPS); }
            if (lane == 0) rr[j] = r; }
        __syncthreads();
        const int c = 2 * tid;
        switch (wave >> 1) { case 0: pooldiff_cols<2>(P, t0, s0, rr, c); break; case 1: pooldiff_cols<4>(P, t0, s0, rr, c); break; case 2: pooldiff_cols<8>(P, t0, s0, rr, c); break; default: pooldiff_cols<16>(P, t0, s0, rr, c); break; }
        __syncthreads();
    }
}

typedef float mf4 __attribute__((ext_vector_type(4)));
__device__ __forceinline__ void phase_router(const Ptrs& P, int l, bf16_t* hb, LAS unsigned char* lds, int G) {
    const int tid = threadIdx.x, lane = tid & 63, wave = __builtin_amdgcn_readfirstlane(tid >> 6), tg = wave & 3, kh = wave >> 2, li = lane & 15, q = lane >> 4;
    LAS float* bbuf = (LAS float*)lds; LAS float* part = (LAS float*)(lds + 53248); LAS float* ssp = (LAS float*)(lds + 79872);
    LAS unsigned* lcnt = (LAS unsigned*)(lds + 80384); LAS unsigned* lbase = (LAS unsigned*)(lds + 80512);
    const float* wrT = (const float*)(P.ws + WS_W + WW_WR) + (size_t)l * 48 * D;
    unsigned* gcnt = (unsigned*)(P.ws + WS_CTL) + CW_CNT + 64 * l; unsigned* list = (unsigned*)(P.ws + WS_LIST);
    float* rout = (float*)(P.ws + WS_RX) + T; float* gwv = (float*)(P.ws + WS_RX) + 2 * T;
    for (int item = blockIdx.x; item < T / 64; item += G) {
        const int row = item * 64 + tg * 16 + li;
        const float* hrow = P.out + (size_t)row * D + kh * 512;
        bf16_t* hbrow = hb + (size_t)row * D + kh * 512;
        if (tid < 32) lcnt[tid] = 0u;
        mf4 acc[3];
#pragma unroll
        for (int i = 0; i < 3; ++i) acc[i] = (mf4){0.f, 0.f, 0.f, 0.f};
        float ss = 0.f;
        f32x4 breg[3], areg[4];
#pragma unroll
        for (int j = 0; j < 3; ++j) { const int f = tid + 512 * j, hh = f / 768, rem = f % 768, n = rem >> 4, c4 = rem & 15; breg[j] = *(const f32x4*)(wrT + (size_t)n * D + hh * 512 + c4 * 4); }
#pragma unroll
        for (int kk = 0; kk < 4; ++kk) areg[kk] = *(const f32x4*)(hrow + kk * 16 + 4 * q);
#pragma unroll
        for (int j = 0; j < 3; ++j) { const int f = tid + 512 * j, hh = f / 768, rem = f % 768, n = rem >> 4, c4 = rem & 15; *(LAS f32x4*)(bbuf + ((hh * 48 + n) * 68 + c4 * 4)) = breg[j]; }
        __syncthreads();
        for (int ch = 0; ch < 8; ++ch) {
            f32x4 acur[4];
#pragma unroll
            for (int kk = 0; kk < 4; ++kk) acur[kk] = areg[kk];
            if (ch + 1 < 8) {
#pragma unroll
                for (int j = 0; j < 3; ++j) { const int f = tid + 512 * j, hh = f / 768, rem = f % 768, n = rem >> 4, c4 = rem & 15; breg[j] = *(const f32x4*)(wrT + (size_t)n * D + hh * 512 + (ch + 1) * 64 + c4 * 4); }
#pragma unroll
                for (int kk = 0; kk < 4; ++kk) areg[kk] = *(const f32x4*)(hrow + (ch + 1) * 64 + kk * 16 + 4 * q);
            }
            const LAS float* bb = bbuf + (ch & 1) * (2 * 48 * 68) + kh * 48 * 68;
#pragma unroll
            for (int kk = 0; kk < 4; ++kk) {
                const f32x4 a = acur[kk];
#pragma unroll
                for (int ntile = 0; ntile < 3; ++ntile) { const f32x4 b = *(const LAS f32x4*)(bb + (ntile * 16 + li) * 68 + kk * 16 + 4 * q);
#pragma unroll
                    for (int s = 0; s < 4; ++s) acc[ntile] = __builtin_amdgcn_mfma_f32_16x16x4f32(a[s], b[s], acc[ntile], 0, 0, 0); }
                ss += (a[0] * a[0] + a[1] * a[1]) + (a[2] * a[2] + a[3] * a[3]);
                u32x2 w; w.x = cvt_pk_bf16(a[0], a[1]); w.y = cvt_pk_bf16(a[2], a[3]); *(u32x2*)(hbrow + ch * 64 + kk * 16 + 4 * q) = w;
            }
            if (ch + 1 < 8) {
#pragma unroll
                for (int j = 0; j < 3; ++j) { const int f = tid + 512 * j, hh = f / 768, rem = f % 768, n = rem >> 4, c4 = rem & 15; *(LAS f32x4*)(bbuf + ((ch + 1) & 1) * (2 * 48 * 68) + ((hh * 48 + n) * 68 + c4 * 4)) = breg[j]; }
            }
            __syncthreads();
        }
        ss += __shfl_xor(ss, 16); ss += __shfl_xor(ss, 32);
        if (q == 0) ssp[kh * 64 + tg * 16 + li] = ss;
#pragma unroll
        for (int ntile = 0; ntile < 3; ++ntile)
#pragma unroll
            for (int rg = 0; rg < 4; ++rg) part[(kh * 64 + tg * 16 + 4 * q + rg) * 49 + ntile * 16 + li] = acc[ntile][rg];
        __syncthreads();
        int ea = 0, eb = 0; unsigned pa = 0, pb = 0; const int t = item * 64 + tid;
        if (tid < 64) {
            const float r = __builtin_amdgcn_rsqf((ssp[tid] + ssp[64 + tid]) * (1.f / D) + EPS);
            float lg[36];
#pragma unroll
            for (int j = 0; j < 36; ++j) lg[j] = (part[tid * 49 + j] + part[(64 + tid) * 49 + j]) * r;
            float gl[4]; int gs = 0; float gm = -1e30f;
#pragma unroll
            for (int j = 0; j < 4; ++j) { gl[j] = lg[32 + j] + P.b_gr[l * 4 + j]; if (gl[j] > gm) { gm = gl[j]; gs = j; } }
            float gsum = 0.f;
#pragma unroll
            for (int j = 0; j < 4; ++j) gsum += __expf(gl[j] - gm);
            const float pg = 1.f / gsum;
            float el[8];
#pragma unroll
            for (int j = 0; j < 8; ++j) { float v = 0.f;
#pragma unroll
                for (int g = 0; g < 4; ++g) v = (g == gs) ? lg[g * 8 + j] : v;
                el[j] = v + P.b_er[l * 32 + gs * 8 + j]; }
            int i0 = 0; float v0 = el[0];
#pragma unroll
            for (int j = 1; j < 8; ++j) if (el[j] > v0) { v0 = el[j]; i0 = j; }
            int i1 = -1; float v1 = -1e30f;
#pragma unroll
            for (int j = 0; j < 8; ++j) if (j != i0 && el[j] > v1) { v1 = el[j]; i1 = j; }
            const float e1 = __expf(v1 - v0); const float g0 = pg / (1.f + e1), g1 = pg * e1 / (1.f + e1);
            rout[t] = r; gwv[2 * t] = g0; gwv[2 * t + 1] = g1;
            ea = gs * 8 + i0; eb = gs * 8 + i1;
            pa = __hip_atomic_fetch_add(&lcnt[ea], 1u, __ATOMIC_RELAXED, __HIP_MEMORY_SCOPE_WORKGROUP); pb = __hip_atomic_fetch_add(&lcnt[eb], 1u, __ATOMIC_RELAXED, __HIP_MEMORY_SCOPE_WORKGROUP);
        }
        __syncthreads();
        if (tid < 32) { const unsigned n = lcnt[tid]; lbase[tid] = n ? atomicAdd(&gcnt[tid], n) : 0u; }
        __syncthreads();
        if (tid < 64) { list[(size_t)ea * T + lbase[ea] + pa] = 2u * t; list[(size_t)eb * T + lbase[eb] + pb] = 2u * t + 1u; }
        __syncthreads();
    }
}

__device__ __forceinline__ void phase_combine(const Ptrs& P, bf16_t* hbn, int vcu, int G) {
    const int lane = threadIdx.x & 63, gw = vcu * NWAVES + (threadIdx.x >> 6), NGW = G * NWAVES;
    for (int row = gw; row < T; row += NGW) {
        f32x4* h = (f32x4*)(P.out + (size_t)row * D) + lane; const u32x2* y = (const u32x2*)((const bf16_t*)(P.ws + WS_Y) + (size_t)row * 2 * D) + lane;
        f32x4 v[4]; float s = 0.f;
#pragma unroll
        for (int j = 0; j < 4; ++j) { v[j] = h[64 * j]; const u32x2 a = y[64 * j], b = y[256 + 64 * j];
            v[j][0] += __uint_as_float(a.x << 16) + __uint_as_float(b.x << 16); v[j][1] += __uint_as_float(a.x & 0xffff0000u) + __uint_as_float(b.x & 0xffff0000u);
            v[j][2] += __uint_as_float(a.y << 16) + __uint_as_float(b.y << 16); v[j][3] += __uint_as_float(a.y & 0xffff0000u) + __uint_as_float(b.y & 0xffff0000u);
            s += (v[j][0] * v[j][0] + v[j][1] * v[j][1]) + (v[j][2] * v[j][2] + v[j][3] * v[j][3]); }
        const float r = __builtin_amdgcn_rsqf(wave_sum(s) * (1.f / D) + EPS);
        u32x2* o = (u32x2*)(hbn + (size_t)row * D) + lane;
#pragma unroll
        for (int j = 0; j < 4; ++j) { h[64 * j] = v[j]; u32x2 w; w.x = cvt_pk_bf16(v[j][0] * r, v[j][1] * r); w.y = cvt_pk_bf16(v[j][2] * r, v[j][3] * r); o[64 * j] = w; }
    }
}
__device__ __forceinline__ void phase_final(const Ptrs& P, int vcu, int G) {
    const int lane = threadIdx.x & 63, gw = vcu * NWAVES + (threadIdx.x >> 6), NGW = G * NWAVES;
    f32x4 gf[4];
#pragma unroll
    for (int j = 0; j < 4; ++j) gf[j] = *((const f32x4*)P.g_final + lane + 64 * j);
    for (int row = gw; row < T; row += NGW) {
        f32x4* h = (f32x4*)(P.out + (size_t)row * D) + lane; f32x4 v[4]; float s = 0.f;
#pragma unroll
        for (int j = 0; j < 4; ++j) { v[j] = h[64 * j]; s += (v[j][0] * v[j][0] + v[j][1] * v[j][1]) + (v[j][2] * v[j][2] + v[j][3] * v[j][3]); }
        const float r = __builtin_amdgcn_rsqf(wave_sum(s) * (1.f / D) + EPS);
#pragma unroll
        for (int j = 0; j < 4; ++j) h[64 * j] = v[j] * r * gf[j];
    }
}
constexpr int AT_KSTR = 144, AT_VSTR = 520, AT_VOFF = 256 * AT_KSTR;
__device__ __forceinline__ int crow16(int reg, int h) { return (reg & 3) + 8 * (reg >> 2) + 4 * h; }
__device__ __forceinline__ void phase_attn(const Ptrs& P, LAS unsigned char* lds, int G) {
    const int tid = threadIdx.x, lane = tid & 63, wave = __builtin_amdgcn_readfirstlane(tid >> 6), r32 = lane & 31, hh = lane >> 5;
    const bf16_t* Qb = (const bf16_t*)(P.ws + WS_Q); const bf16_t* Kb = (const bf16_t*)(P.ws + WS_K); const bf16_t* Vb = (const bf16_t*)(P.ws + WS_V); bf16_t* Ob = (bf16_t*)(P.ws + WS_O);
    for (int unit = blockIdx.x; unit < 2 * 64 * 4; unit += G) {
        const int kh = unit & 3, nb = (unit >> 2) & 63, b = unit >> 8;
        const int tq0 = b * SEQ + nb * 128;
        __syncthreads();
        {
            const int key = tid >> 1, hf = tid & 1; const bool ok = (nb > 0) || (key >= 128);
            u32x4 kv[4], vv[4];
#pragma unroll
            for (int i = 0; i < 4; ++i) { kv[i] = (u32x4){0u, 0u, 0u, 0u}; vv[i] = (u32x4){0u, 0u, 0u, 0u}; }
            if (ok) { const size_t go = (size_t)(tq0 - 128 + key) * KD + kh * 64 + hf * 32;
#pragma unroll
                for (int i = 0; i < 4; ++i) { kv[i] = *(const u32x4*)(Kb + go + 8 * i); vv[i] = *(const u32x4*)(Vb + go + 8 * i); } }
#pragma unroll
            for (int i = 0; i < 4; ++i) *(LAS u32x4*)(lds + key * AT_KSTR + hf * 64 + 16 * i) = kv[i];
#pragma unroll
            for (int i = 0; i < 4; ++i)
#pragma unroll
                for (int e = 0; e < 4; ++e) { const unsigned w = vv[i][e]; const int d = hf * 32 + 8 * i + 2 * e;
                    *(LAS bf16_t*)(lds + AT_VOFF + d * AT_VSTR + key * 2) = (bf16_t)(w & 0xffffu); *(LAS bf16_t*)(lds + AT_VOFF + (d + 1) * AT_VSTR + key * 2) = (bf16_t)(w >> 16); }
        }
        __syncthreads();
        const int g = wave >> 1, head = kh * 4 + g; const float sink = P.sinks[head] * LOG2E;
        for (int qq = 0; qq < 2; ++qq) {
            const int qi = (wave & 1) * 2 + qq;
            const int tq = tq0 + qi * 32 + r32;
            bf16x8 qf[4];
#pragma unroll
            for (int s = 0; s < 4; ++s) qf[s] = *(const bf16x8*)(Qb + (size_t)tq * D + head * 64 + 16 * s + 8 * hh);
            f32x16 st[5];
#pragma unroll
            for (int kt = 0; kt < 5; ++kt) {
                f32x16 a;
#pragma unroll
                for (int i = 0; i < 16; ++i) a[i] = 0.f;
                const LAS unsigned char* kp = lds + (32 * (qi + kt) + r32) * AT_KSTR + 16 * hh;
#pragma unroll
                for (int s = 0; s < 4; ++s) { const bf16x8 kf = *(const LAS bf16x8*)(kp + 32 * s); a = __builtin_amdgcn_mfma_f32_32x32x16_bf16(kf, qf[s], a, 0, 0, 0); }
                st[kt] = a;
            }
            const int iq = qi * 32 + r32;
            float mx = sink;
#pragma unroll
            for (int kt = 0; kt < 5; ++kt)
#pragma unroll
                for (int i = 0; i < 16; ++i) { const int jb = 32 * (qi + kt) + crow16(i, hh); const bool valid = (jb > iq) && (jb <= iq + 128) && (nb > 0 || jb >= 128);
                    const float v = valid ? st[kt][i] : -1e30f; st[kt][i] = v; mx = fmaxf(mx, v); }
            mx = fmaxf(mx, __shfl_xor(mx, 32));
            float sum = 0.f;
#pragma unroll
            for (int kt = 0; kt < 5; ++kt)
#pragma unroll
                for (int i = 0; i < 16; ++i) { const float e = __builtin_amdgcn_exp2f(st[kt][i] - mx); st[kt][i] = e; sum += e; }
            sum += __shfl_xor(sum, 32);
            const float inv = 1.f / (sum + __builtin_amdgcn_exp2f(sink - mx));
            f32x16 o0, o1;
#pragma unroll
            for (int i = 0; i < 16; ++i) { o0[i] = 0.f; o1[i] = 0.f; }
#pragma unroll
            for (int kt = 0; kt < 5; ++kt)
#pragma unroll
                for (int s = 0; s < 2; ++s) {
                    u32x4 pw; pw.x = cvt_pk_bf16(st[kt][8 * s + 0], st[kt][8 * s + 1]); pw.y = cvt_pk_bf16(st[kt][8 * s + 2], st[kt][8 * s + 3]);
                    pw.z = cvt_pk_bf16(st[kt][8 * s + 4], st[kt][8 * s + 5]); pw.w = cvt_pk_bf16(st[kt][8 * s + 6], st[kt][8 * s + 7]);
                    const bf16x8 pf = __builtin_bit_cast(bf16x8, pw);
                    const int key0 = 32 * (qi + kt) + 16 * s + 4 * hh;
                    const LAS unsigned char* vp0 = lds + AT_VOFF + r32 * AT_VSTR + key0 * 2; const LAS unsigned char* vp1 = vp0 + 32 * AT_VSTR;
                    const s16x4 a00 = *(const LAS s16x4*)(vp0), a01 = *(const LAS s16x4*)(vp0 + 16), a10 = *(const LAS s16x4*)(vp1), a11 = *(const LAS s16x4*)(vp1 + 16);
                    const bf16x8 v0 = __builtin_shufflevector(a00, a01, 0, 1, 2, 3, 4, 5, 6, 7), v1 = __builtin_shufflevector(a10, a11, 0, 1, 2, 3, 4, 5, 6, 7);
                    o0 = __builtin_amdgcn_mfma_f32_32x32x16_bf16(v0, pf, o0, 0, 0, 0);
                    o1 = __builtin_amdgcn_mfma_f32_32x32x16_bf16(v1, pf, o1, 0, 0, 0);
                }
            bf16_t* op = Ob + (size_t)tq * D + head * 64 + 4 * hh;
#pragma unroll
            for (int gq = 0; gq < 4; ++gq) {
                u32x2 w0, w1; w0.x = cvt_pk_bf16(o0[4 * gq] * inv, o0[4 * gq + 1] * inv); w0.y = cvt_pk_bf16(o0[4 * gq + 2] * inv, o0[4 * gq + 3] * inv);
                w1.x = cvt_pk_bf16(o1[4 * gq] * inv, o1[4 * gq + 1] * inv); w1.y = cvt_pk_bf16(o1[4 * gq + 2] * inv, o1[4 * gq + 3] * inv);
                *(u32x2*)(op + 8 * gq) = w0; *(u32x2*)(op + 32 + 8 * gq) = w1;
            }
        }
    }
}

constexpr int NPHASE = 16;
struct Args { Ptrs P; int ph_lo, ph_hi; };
__global__ void __launch_bounds__(NTHREADS, 2) yoco_fwd(Args args) {
    extern __shared__ __attribute__((aligned(16))) unsigned char lds_raw[];
    LAS unsigned char* lds = (LAS unsigned char*)lds_raw;
    const Ptrs& P = args.P;
    const int tid = threadIdx.x, G = gridDim.x, bx = blockIdx.x;
    const int vcu = (G % 8 == 0) ? (bx % 8) * (G / 8) + bx / 8 : bx;
    volatile LAS unsigned* MISC = (volatile LAS unsigned*)(lds + MISC_OFF);
    if (tid < 4) MISC[tid] = 0u;
    __syncthreads();
    const int lo = args.ph_lo, hi = args.ph_hi;
    const bool multi = (hi - lo) > 1;
    XcdBarrier bar; bar.bar = (unsigned*)(P.ws + WS_CTL) + CW_BAR; bar.x = 0; bar.st = MISC;
    if (multi) bar = xcd_barrier_post((unsigned*)(P.ws + WS_CTL) + CW_BAR, MISC);
    bf16_t* HBA = (bf16_t*)(P.ws + WS_HBA); bf16_t* HBB = (bf16_t*)(P.ws + WS_HBB);
    LAS int* tt = (LAS int*)(lds + TT_OFF);
#ifdef ONLY_PH
#define IN(k) ((k) == ONLY_PH)
#else
#define IN(k) (lo <= (k) && (k) < hi)
#endif
#define SEAM(k) do { if (IN(k) && IN((k) + 1)) xcd_barrier(bar); } while (0)
    if (IN(0)) { phase_prologue(P, lds, vcu, G); } SEAM(0);
    if (IN(1)) {
#if !defined(SKIP_POOL)
        { JobPool J; J.P = P; J.G = G; J.c = bx; g8::gemm_phase(lds, J); }
#endif
#if !defined(SKIP_UP)
        { JobUp J; J.P = P; J.G = G; J.c = bx; g8::gemm_phase(lds, J); }
#endif
    } SEAM(1);
    if (IN(2)) { phase_router(P, 0, HBA, lds, G); } SEAM(2);
    if (IN(3)) { build_tile_table(P, 0, tt); JobGateUp J; J.P = P; J.G = G; J.c = bx; J.l = 0; J.hb = HBA; J.tt = tt; g8::gemm_phase(lds, J); } SEAM(3);
    if (IN(4)) { build_tile_table(P, 0, tt); JobDown J; J.P = P; J.G = G; J.c = bx; J.l = 0; J.tt = tt; g8::gemm_phase(lds, J); } SEAM(4);
    if (IN(5)) { phase_combine(P, HBB, vcu, G); } SEAM(5);
    if (IN(6)) { JobPle J; J.P = P; J.G = G; J.c = bx; J.l = 0; J.hbn = HBB; J.hb3 = HBA; g8::gemm_phase(lds, J); } SEAM(6);
    if (IN(7)) { JobKvq J; J.P = P; J.G = G; J.c = bx; J.hb3 = HBA; g8::gemm_phase(lds, J); } SEAM(7);
    if (IN(8)) { phase_attn(P, lds, G); __syncthreads(); } SEAM(8);
    if (IN(9)) { JobOproj J; J.P = P; J.G = G; J.c = bx; g8::gemm_phase(lds, J); } SEAM(9);
    if (IN(10)) { phase_router(P, 1, HBA, lds, G); } SEAM(10);
    if (IN(11)) { build_tile_table(P, 1, tt); JobGateUp J; J.P = P; J.G = G; J.c = bx; J.l = 1; J.hb = HBA; J.tt = tt; g8::gemm_phase(lds, J); } SEAM(11);
    if (IN(12)) { build_tile_table(P, 1, tt); JobDown J; J.P = P; J.G = G; J.c = bx; J.l = 1; J.tt = tt; g8::gemm_phase(lds, J); } SEAM(12);
    if (IN(13)) { phase_combine(P, HBB, vcu, G); } SEAM(13);
    if (IN(14)) { JobPle J; J.P = P; J.G = G; J.c = bx; J.l = 1; J.hbn = HBB; J.hb3 = nullptr; g8::gemm_phase(lds, J); } SEAM(14);
    if (IN(15)) { phase_final(P, vcu, G); }
#undef IN
#undef SEAM
}
#if HYBRID
__global__ void k_rms_x(Ptrs P) {
    const int row = blockIdx.x * 4 + (threadIdx.x >> 6), lane = threadIdx.x & 63;
    const float* xr = P.x + (size_t)row * D; float s = 0.f;
    for (int i = lane; i < D; i += 64) s += xr[i] * xr[i];
    s = wave_sum(s);
    if (lane == 0) ((float*)(P.ws + WS_RX))[row] = rsqrtf(s * (1.f / D) + EPS);
}
__global__ void k_cs(Ptrs P) {
    const int i = blockIdx.x * blockDim.x + threadIdx.x; if (i >= T * 32) return;
    const int t = i >> 5, j = i & 31;
    const float inv = powf(10000.f, -(float)(2 * j) / 64.f);
    const float ang = (float)P.pos[t] * inv;
    const double a = (double)ang; const double rev = a * 0.15915494309189535; const double fr = rev - rint(rev);
    const float f = (float)fr * 6.283185307179586f;
    ((float2*)(P.ws + WS_CS))[i] = make_float2(cosf(f), sinf(f));
}
__global__ void k_pooldiff(Ptrs P) {
    const size_t i = (size_t)blockIdx.x * blockDim.x + threadIdx.x; const int t = (int)(i >> 10), c = (int)(i & 1023);
    const int gi = c >> 8, w = 2 << gi, s = t & (SEQ - 1); const int cnt = (s + 1 < w) ? s + 1 : w;
    const float* rx = (const float*)(P.ws + WS_RX); const float g = P.g_mix[c];
    float sum = 0.f;
    for (int j = 0; j < cnt; ++j) sum += P.x[(size_t)(t - j) * D + c] * rx[t - j] * g;
    const float hn = P.x[(size_t)t * D + c] * rx[t] * g;
    ((bf16_t*)(P.ws + WS_D16))[i] = f2bf(sum / (float)cnt - hn);
}
__global__ void k_p16(Ptrs P) {
    const size_t i = (size_t)blockIdx.x * blockDim.x + threadIdx.x; if (i >= (size_t)2 * T * PD) return;
    ((bf16_t*)(P.ws + WS_P16))[i] = f2bf(P.p[i]);
}
template <class F> __global__ void k_ngemm(F f) {
    const int n = blockIdx.x * 256 + threadIdx.x, m0 = blockIdx.y * 8;
    if (!f.begin(m0)) return;
    f.m0 = m0;
    float acc[8], acc2[8];
#pragma unroll
    for (int i = 0; i < 8; ++i) { acc[i] = 0.f; acc2[i] = 0.f; }
    const int K = f.K();
    for (int k = 0; k < K; ++k) {
        float w, w2; f.w(k, n, w, w2);
#pragma unroll
        for (int i = 0; i < 8; ++i) { const float a = f.a(i, k); acc[i] += a * w; acc2[i] += a * w2; }
    }
#pragma unroll
    for (int i = 0; i < 8; ++i) f.epi(i, n, acc[i], acc2[i]);
}
struct FPool {
    Ptrs P; int m0;
    __device__ bool begin(int) { return true; }
    __device__ int K() const { return 256; }
    __device__ void w(int k, int n, float& w, float& w2) const { w = P.pool_w[((size_t)(n >> 8) * 256 + k) * 256 + (n & 255)]; w2 = 0.f; }
    __device__ float a(int i, int k) const { return bf2f(((const bf16_t*)(P.ws + WS_D16))[(size_t)(m0 + i) * D + (blockIdx.x) * 256 + k]); }
    __device__ void epi(int i, int n, float acc, float) const { const int m = m0 + i; P.out[(size_t)m * D + n] = P.x[(size_t)m * D + n] + acc * P.pool_scale[n]; }
};
struct FUp {
    Ptrs P; int l; int m0;
    __device__ bool begin(int) { return true; }
    __device__ int K() const { return PD; }
    __device__ void w(int k, int n, float& w, float& w2) const { w = P.w_pu[((size_t)l * PD + k) * D + n]; w2 = 0.f; }
    __device__ float a(int i, int k) const { return bf2f(((const bf16_t*)(P.ws + WS_P16))[((size_t)l * T + m0 + i) * PD + k]); }
    __device__ void epi(int i, int n, float acc, float) const { ((bf16_t*)(P.ws + WS_U))[((size_t)l * T + m0 + i) * D + n] = f2bf(acc); }
};
__global__ void k_router(Ptrs P, int l, bf16_t* hb) {
    const int t = blockIdx.x * blockDim.x + threadIdx.x; if (t >= T) return;
    const float* h = P.out + (size_t)t * D;
    float lg[36];
#pragma unroll
    for (int j = 0; j < 36; ++j) lg[j] = 0.f;
    float ss = 0.f;
    for (int k = 0; k < D; ++k) {
        const float v = h[k]; ss += v * v; hb[(size_t)t * D + k] = f2bf(v);
        const float hv = v * P.g_ffn[l * D + k];
#pragma unroll
        for (int j = 0; j < 32; ++j) lg[j] += hv * P.w_er[((size_t)l * D + k) * 32 + j];
#pragma unroll
        for (int j = 0; j < 4; ++j) lg[32 + j] += hv * P.w_gr[((size_t)l * D + k) * 4 + j];
    }
    const float r = rsqrtf(ss * (1.f / D) + EPS);
    ((float*)(P.ws + WS_RX))[T + t] = r;
    float gl[4]; int gs = 0; float gm = -1e30f;
#pragma unroll
    for (int j = 0; j < 4; ++j) { gl[j] = lg[32 + j] * r + P.b_gr[l * 4 + j]; if (gl[j] > gm) { gm = gl[j]; gs = j; } }
    float gsum = 0.f;
#pragma unroll
    for (int j = 0; j < 4; ++j) gsum += expf(gl[j] - gm);
    const float pg = 1.f / gsum;
    float el[8];
#pragma unroll
    for (int j = 0; j < 8; ++j) {
        float v = 0.f;
#pragma unroll
        for (int g = 0; g < 4; ++g) v = (g == gs) ? lg[g * 8 + j] : v;
        el[j] = v * r + P.b_er[l * 32 + gs * 8 + j];
    }
    int i0 = 0; float v0 = el[0];
#pragma unroll
    for (int j = 1; j < 8; ++j) if (el[j] > v0) { v0 = el[j]; i0 = j; }
    int i1 = -1; float v1 = -1e30f;
#pragma unroll
    for (int j = 0; j < 8; ++j) if (j != i0 && el[j] > v1) { v1 = el[j]; i1 = j; }
    const float e1 = expf(v1 - v0); const float g0 = pg / (1.f + e1), g1 = pg * e1 / (1.f + e1);
    float* gw = (float*)(P.ws + WS_RX) + 2 * T;
    gw[2 * t] = g0; gw[2 * t + 1] = g1;
    unsigned* cnt = (unsigned*)(P.ws + WS_CTL) + CW_CNT + 64 * l; unsigned* list = (unsigned*)(P.ws + WS_LIST);
    const int ea = gs * 8 + i0, eb = gs * 8 + i1;
    const unsigned pa = atomicAdd(&cnt[ea], 1u); list[(size_t)ea * T + pa] = 2u * t;
    const unsigned pb = atomicAdd(&cnt[eb], 1u); list[(size_t)eb * T + pb] = 2u * t + 1u;
}
__device__ __forceinline__ bool tile_lookup(const unsigned* cnt, int tile, int& e, int& j, int& c) {
    int tb = 0;
    for (int i = 0; i < NE; ++i) { const int ci = (int)cnt[i], nt = (ci + 255) >> 8; if (tile < tb + nt) { e = i; j = tile - tb; c = ci; return true; } tb += nt; }
    return false;
}
struct FGateUp {
    Ptrs P; int l; const bf16_t* hb; int e, j, c; int m0; int en[8];
    __device__ bool begin(int mm) { if (!tile_lookup((const unsigned*)(P.ws + WS_CTL) + CW_CNT + 64 * l, mm >> 8, e, j, c)) return false;
#pragma unroll
        for (int i = 0; i < 8; ++i) en[i] = ent(mm + i);
        return true; }
    __device__ int K() const { return D; }
    __device__ void w(int k, int n, float& w, float& w2) const { const float g = P.g_ffn[l * D + k];
        w = g * P.w_eg[(((size_t)l * NE + e) * D + k) * DE + n]; w2 = g * P.w_eu[(((size_t)l * NE + e) * D + k) * DE + n]; }
    __device__ int ent(int m) const { int idx = j * 256 + (m & 255); if (idx >= c) idx = c - 1; return (int)((const unsigned*)(P.ws + WS_LIST))[(size_t)e * T + idx]; }
    __device__ float a(int i, int k) const { return bf2f(hb[(size_t)(en[i] >> 1) * D + k]); }
    __device__ void epi(int i, int n, float G, float U) const { const int m = m0 + i; const float r = ((const float*)(P.ws + WS_RX))[T + (en[i] >> 1)], gw = ((const float*)(P.ws + WS_RX))[2 * T + en[i]];
        G *= r; U *= r; const float a = gw * (G / (1.f + __expf(-G))) * U; ((bf16_t*)(P.ws + WS_ACT))[(size_t)m * DE + n] = f2bf(a); }
};
struct FDown {
    Ptrs P; int l; int e, j, c; int m0;
    __device__ bool begin(int mm) { return tile_lookup((const unsigned*)(P.ws + WS_CTL) + CW_CNT + 64 * l, mm >> 8, e, j, c); }
    __device__ int K() const { return DE; }
    __device__ void w(int k, int n, float& w, float& w2) const { w = P.w_ed[(((size_t)l * NE + e) * DE + k) * D + n]; w2 = 0.f; }
    __device__ float a(int i, int k) const { return bf2f(((const bf16_t*)(P.ws + WS_ACT))[(size_t)(m0 + i) * DE + k]); }
    __device__ void epi(int i, int n, float acc, float) const { const int m = m0 + i; const int idx = j * 256 + (m & 255); if (idx >= c) return;
        const unsigned en = ((const unsigned*)(P.ws + WS_LIST))[(size_t)e * T + idx]; ((bf16_t*)(P.ws + WS_Y))[(size_t)en * D + n] = f2bf(acc); }
};
__global__ void k_combine(Ptrs P, bf16_t* hbn) {
    const int row = blockIdx.x * 4 + (threadIdx.x >> 6), lane = threadIdx.x & 63;
    float* h = P.out + (size_t)row * D; const bf16_t* y = (const bf16_t*)(P.ws + WS_Y) + (size_t)row * 2 * D;
    float v[16]; float s = 0.f;
#pragma unroll
    for (int i = 0; i < 16; ++i) { const int c = lane + 64 * i; v[i] = h[c] + bf2f(y[c]) + bf2f(y[D + c]); s += v[i] * v[i]; }
    s = wave_sum(s); const float r = rsqrtf(s * (1.f / D) + EPS);
#pragma unroll
    for (int i = 0; i < 16; ++i) { const int c = lane + 64 * i; h[c] = v[i]; hbn[(size_t)row * D + c] = f2bf(v[i] * r); }
}
struct FPle {
    Ptrs P; int l; const bf16_t* hbn; bf16_t* hb3; int m0;
    __device__ bool begin(int) { return true; }
    __device__ int K() const { return D; }
    __device__ void w(int k, int n, float& w, float& w2) const { w = P.g_ple[l * D + k] * P.w_pg[((size_t)l * D + k) * D + n]; w2 = 0.f; }
    __device__ float a(int i, int k) const { return bf2f(hbn[(size_t)(m0 + i) * D + k]); }
    __device__ void epi(int i, int n, float G, float) const { const int m = m0 + i; const float u = bf2f(((const bf16_t*)(P.ws + WS_U))[((size_t)l * T + m) * D + n]);
        const float h = P.out[(size_t)m * D + n] + u / (1.f + __expf(-G)); P.out[(size_t)m * D + n] = h;
        if (hb3) { hb3[(size_t)m * D + n] = f2bf(h); atomicAdd((float*)(P.ws + WS_CTL) + CW_SS3 + m, h * h); } }
};
struct FKvq {
    Ptrs P; const bf16_t* hb3; int m0;
    __device__ bool begin(int) { return true; }
    __device__ int K() const { return D; }
    __device__ void w(int k, int n, float& w, float& w2) const {
        if (n < 256) { const int kh = n >> 6, c = n & 63, d = (c >> 1) + 32 * (c & 1), dp = d ^ 32; const float g = P.g_kv[k]; w = g * P.w_k[(size_t)k * KD + kh * 64 + d]; w2 = g * P.w_k[(size_t)k * KD + kh * 64 + dp]; }
        else if (n < 512) { w = P.g_kv[k] * P.w_v[(size_t)k * KD + (n - 256)]; w2 = 0.f; }
        else { const int q = n - 512, hh = q >> 6, c = q & 63, d = (c >> 1) + 32 * (c & 1), dp = d ^ 32; const float g = P.g_mix[D + k]; w = g * P.w_q[(size_t)k * D + hh * 64 + d]; w2 = g * P.w_q[(size_t)k * D + hh * 64 + dp]; }
    }
    __device__ float a(int i, int k) const { return bf2f(hb3[(size_t)(m0 + i) * D + k]); }
    __device__ void epi(int i, int n, float a1, float a2) const { const int m = m0 + i;
        const float r = rsqrtf(((const float*)(P.ws + WS_CTL))[CW_SS3 + m] * (1.f / D) + EPS); a1 *= r; a2 *= r;
        if (n >= 256 && n < 512) { ((bf16_t*)(P.ws + WS_V))[(size_t)m * KD + (n - 256)] = f2bf(a1); return; }
        const int c = n & 63, pi = c >> 1; const float2 cs = ((const float2*)(P.ws + WS_CS))[(size_t)m * 32 + pi];
        const float o = (c & 1) ? (a1 * cs.x + a2 * cs.y) : (a1 * cs.x - a2 * cs.y);
        if (n < 256) ((bf16_t*)(P.ws + WS_K))[(size_t)m * KD + n] = f2bf(o);
        else ((bf16_t*)(P.ws + WS_Q))[(size_t)m * D + (n - 512)] = f2bf(o * QSCALE);
    }
};
__global__ void __launch_bounds__(64) k_attn(Ptrs P) {
    const int i = blockIdx.x * blockDim.x + threadIdx.x; const int t = i >> 4, h = i & 15, kh = h >> 2, s = t & (SEQ - 1);
    const bf16_t* Q = (const bf16_t*)(P.ws + WS_Q) + (size_t)t * D + h * 64; const bf16_t* Kb = (const bf16_t*)(P.ws + WS_K); const bf16_t* Vb = (const bf16_t*)(P.ws + WS_V);
    float q[64];
#pragma unroll
    for (int d = 0; d < 64; ++d) q[d] = bf2f(Q[d]);
    const int nk = (s + 1 < 128) ? s + 1 : 128; const float sink = P.sinks[h] * LOG2E;
    float m = sink;
    for (int j = 0; j < nk; ++j) { const bf16_t* kr = Kb + (size_t)(t - j) * KD + kh * 64; float sc = 0.f;
#pragma unroll
        for (int d = 0; d < 64; ++d) sc += q[d] * bf2f(kr[d]);
        m = fmaxf(m, sc); }
    float o[64];
#pragma unroll
    for (int d = 0; d < 64; ++d) o[d] = 0.f;
    float den = exp2f(sink - m);
    for (int j = 0; j < nk; ++j) { const bf16_t* kr = Kb + (size_t)(t - j) * KD + kh * 64; const bf16_t* vr = Vb + (size_t)(t - j) * KD + kh * 64; float sc = 0.f;
#pragma unroll
        for (int d = 0; d < 64; ++d) sc += q[d] * bf2f(kr[d]);
        const float e = exp2f(sc - m); den += e;
#pragma unroll
        for (int d = 0; d < 64; ++d) o[d] += e * bf2f(vr[d]); }
    const float inv = 1.f / den; bf16_t* O = (bf16_t*)(P.ws + WS_O) + (size_t)t * D + h * 64;
#pragma unroll
    for (int d = 0; d < 64; ++d) O[d] = f2bf(o[d] * inv);
}
struct FOproj {
    Ptrs P; int m0;
    __device__ bool begin(int) { return true; }
    __device__ int K() const { return D; }
    __device__ void w(int k, int n, float& w, float& w2) const { w = P.w_o[(size_t)k * D + n]; w2 = 0.f; }
    __device__ float a(int i, int k) const { return bf2f(((const bf16_t*)(P.ws + WS_O))[(size_t)(m0 + i) * D + k]); }
    __device__ void epi(int i, int n, float acc, float) const { P.out[(size_t)(m0 + i) * D + n] += acc; }
};
__global__ void k_final(Ptrs P) {
    const int row = blockIdx.x * 4 + (threadIdx.x >> 6), lane = threadIdx.x & 63;
    float* h = P.out + (size_t)row * D; float v[16]; float s = 0.f;
#pragma unroll
    for (int i = 0; i < 16; ++i) { v[i] = h[lane + 64 * i]; s += v[i] * v[i]; }
    s = wave_sum(s); const float r = rsqrtf(s * (1.f / D) + EPS);
#pragma unroll
    for (int i = 0; i < 16; ++i) h[lane + 64 * i] = v[i] * r * P.g_final[lane + 64 * i];
}

#endif
#ifndef HYBRID
#define HYBRID 0
#endif
#ifndef NAIVE_MASK
#define NAIVE_MASK 0u
#endif
extern "C" void kernel_launch(void* const* d_in, const int* in_sizes, int n_in, void* d_out, int out_size, void* d_ws, size_t ws_size, hipStream_t stream) {
    static int grid = 0;
    if (grid == 0) {
        if (n_in != 24 || in_sizes[0] != T * D || out_size != T * D || ws_size < WS_END) { fprintf(stderr, "kernel_launch: unexpected problem (n_in %d, ws %zu)\n", n_in, ws_size); grid = -1; return; }
        int dev = 0, cus = 0, per_cu = 0;
        if (hipGetDevice(&dev) != hipSuccess || hipDeviceGetAttribute(&cus, hipDeviceAttributeMultiprocessorCount, dev) != hipSuccess) { grid = -1; return; }
        if (hipFuncSetAttribute((const void*)yoco_fwd, hipFuncAttributeMaxDynamicSharedMemorySize, LDS_BYTES) != hipSuccess) { fprintf(stderr, "kernel_launch: hipFuncSetAttribute failed\n"); grid = -1; return; }
        if (hipOccupancyMaxActiveBlocksPerMultiprocessor(&per_cu, (const void*)yoco_fwd, NTHREADS, LDS_BYTES) != hipSuccess || per_cu < 1) { fprintf(stderr, "kernel_launch: occupancy query says %d\n", per_cu); }
        (void)hipGetLastError();
        grid = cus;
    }
    if (grid < 0) return;
    Ptrs P; memset(&P, 0, sizeof P);
    P.x = (const float*)d_in[0]; P.p = (const float*)d_in[1]; P.pos = (const int*)d_in[2]; P.g_mix = (const float*)d_in[3]; P.g_ffn = (const float*)d_in[4];
    P.pool_w = (const float*)d_in[5]; P.pool_scale = (const float*)d_in[6]; P.g_kv = (const float*)d_in[7]; P.w_k = (const float*)d_in[8]; P.w_v = (const float*)d_in[9];
    P.w_q = (const float*)d_in[10]; P.w_o = (const float*)d_in[11]; P.sinks = (const float*)d_in[12]; P.w_gr = (const float*)d_in[13]; P.b_gr = (const float*)d_in[14];
    P.w_er = (const float*)d_in[15]; P.b_er = (const float*)d_in[16]; P.w_eg = (const float*)d_in[17]; P.w_eu = (const float*)d_in[18]; P.w_ed = (const float*)d_in[19];
    P.g_ple = (const float*)d_in[20]; P.w_pg = (const float*)d_in[21]; P.w_pu = (const float*)d_in[22]; P.g_final = (const float*)d_in[23];
    P.out = (float*)d_out; P.ws = (unsigned char*)d_ws;
    (void)hipMemsetAsync(P.ws + WS_CTL, 0, 1 * MiB, stream);
    Args a; memset(&a, 0, sizeof a); a.P = P;
#if !HYBRID
    a.ph_lo = 0; a.ph_hi = NPHASE;
    hipLaunchKernelGGL(yoco_fwd, dim3(grid), dim3(NTHREADS), LDS_BYTES, stream, a);
#else
    bf16_t* HBA = (bf16_t*)(P.ws + WS_HBA); bf16_t* HBB = (bf16_t*)(P.ws + WS_HBB);
    for (int ph = 0; ph < NPHASE; ++ph) {
        const bool naive = (NAIVE_MASK >> ph) & 1u;
        if (!naive || ph == 0) { a.ph_lo = ph; a.ph_hi = ph + 1; hipLaunchKernelGGL(yoco_fwd, dim3(grid), dim3(NTHREADS), LDS_BYTES, stream, a); }
        if (!naive) continue;
        const int l = ph >= 10 ? 1 : 0;
        switch (ph) {
        case 0: k_rms_x<<<T / 4, 256, 0, stream>>>(P); k_cs<<<T * 32 / 256, 256, 0, stream>>>(P); k_pooldiff<<<T * D / 256, 256, 0, stream>>>(P); k_p16<<<2 * T * PD / 256, 256, 0, stream>>>(P); break;
        case 1: { FPool f; memset(&f, 0, sizeof f); f.P = P; k_ngemm<FPool><<<dim3(4, T / 8), 256, 0, stream>>>(f); }
                for (int ll = 0; ll < 2; ++ll) { FUp f; memset(&f, 0, sizeof f); f.P = P; f.l = ll; k_ngemm<FUp><<<dim3(4, T / 8), 256, 0, stream>>>(f); } break;
        case 2: case 10: k_router<<<T / 64, 64, 0, stream>>>(P, l, HBA); break;
        case 3: case 11: { FGateUp f; memset(&f, 0, sizeof f); f.P = P; f.l = l; f.hb = HBA; k_ngemm<FGateUp><<<dim3(2, 160 * 256 / 8), 256, 0, stream>>>(f); } break;
        case 4: case 12: { FDown f; memset(&f, 0, sizeof f); f.P = P; f.l = l; k_ngemm<FDown><<<dim3(4, 160 * 256 / 8), 256, 0, stream>>>(f); } break;
        case 5: case 13: k_combine<<<T / 4, 256, 0, stream>>>(P, HBB); break;
        case 6: case 14: { FPle f; memset(&f, 0, sizeof f); f.P = P; f.l = l; f.hbn = HBB; f.hb3 = (l == 0) ? HBA : nullptr; k_ngemm<FPle><<<dim3(4, T / 8), 256, 0, stream>>>(f); } break;
        case 7: { FKvq f; memset(&f, 0, sizeof f); f.P = P; f.hb3 = HBA; k_ngemm<FKvq><<<dim3(6, T / 8), 256, 0, stream>>>(f); } break;
        case 8: k_attn<<<T * 16 / 64, 64, 0, stream>>>(P); break;
        case 9: { FOproj f; memset(&f, 0, sizeof f); f.P = P; k_ngemm<FOproj><<<dim3(4, T / 8), 256, 0, stream>>>(f); } break;
        case 15: k_final<<<T / 4, 256, 0, stream>>>(P); break;
        }
    }
#endif
}
```

```cpp
#define HYBRID 0
#define NAIVE_MASK 0u
#define REPEAT_MASK 0u
#include <hip/hip_runtime.h>
#include <cstdio>
#include <cstdint>
#include <cstring>

#define LAS __attribute__((address_space(3)))
typedef unsigned short bf16_t;
typedef short bf16x8 __attribute__((ext_vector_type(8)));
typedef short s16x4 __attribute__((ext_vector_type(4)));
typedef float f32x2 __attribute__((ext_vector_type(2)));
typedef float f32x4 __attribute__((ext_vector_type(4)));
typedef float f32x16 __attribute__((ext_vector_type(16)));
typedef unsigned u32x2 __attribute__((ext_vector_type(2)));
typedef unsigned u32x4 __attribute__((ext_vector_type(4)));

constexpr int T = 16384, D = 1024, SEQ = 8192, NE = 32, DE = 512, PD = 256, HD = 64, NQH = 16, NKVH = 4, KD = 256;
constexpr float EPS = 1e-6f;
constexpr float LOG2E = 1.4426950408889634f;
constexpr float QSCALE = 0.125f * LOG2E;
constexpr int NTHREADS = 512, NWAVES = 8;

__device__ __forceinline__ bf16_t f2bf(float f) { unsigned u = __float_as_uint(f); u += 0x7fffu + ((u >> 16) & 1u); return (bf16_t)(u >> 16); }
__device__ __forceinline__ float bf2f(bf16_t b) { return __uint_as_float(((unsigned)b) << 16); }
__device__ __forceinline__ unsigned cvt_pk_bf16(float lo, float hi) { unsigned r; asm volatile("v_cvt_pk_bf16_f32 %0, %1, %2" : "=v"(r) : "v"(lo), "v"(hi)); return r; }
__device__ __forceinline__ float wave_sum(float v) {
#pragma unroll
    for (int o = 1; o < 64; o <<= 1) v += __shfl_xor(v, o);
    return v;
}
__device__ __forceinline__ float fast_sigmoid(float x) { return __builtin_amdgcn_rcpf(1.f + __builtin_amdgcn_exp2f(-x * LOG2E)); }

constexpr size_t MiB = 1u << 20;
constexpr size_t WS_CTL = 0;
constexpr size_t WS_CS = 1 * MiB;
constexpr size_t WS_RX = 5 * MiB;
constexpr size_t WS_LIST = 6 * MiB;
constexpr size_t WS_U = 8 * MiB;
constexpr size_t WS_HBA = 72 * MiB;
constexpr size_t WS_HBB = 104 * MiB;
constexpr size_t WS_ACT = 136 * MiB;
constexpr size_t WS_Y = 176 * MiB;
constexpr size_t WS_W = 240 * MiB;
constexpr size_t WS_P16 = WS_ACT;
constexpr size_t WS_D16 = WS_Y;
constexpr size_t WS_Q = WS_Y;
constexpr size_t WS_O = WS_Y + 32 * MiB;
constexpr size_t WS_K = WS_ACT;
constexpr size_t WS_V = WS_ACT + 8 * MiB;
constexpr size_t WW_GU = 0;
constexpr size_t WW_DN = 128 * MiB;
constexpr size_t WW_PLEG = 192 * MiB;
constexpr size_t WW_PLEU = 196 * MiB;
constexpr size_t WW_KVQ = 197 * MiB;
constexpr size_t WW_WO = 200 * MiB;
constexpr size_t WW_POOL = 202 * MiB;
constexpr size_t WW_WR = 203 * MiB;
constexpr size_t WS_END = WS_W + 204 * MiB;
constexpr int CW_BAR = 4096;
constexpr int CW_CNT = 8192;
constexpr int CW_SS3 = 16384;

struct Ptrs {
    const float *x, *p; const int* pos; const float *g_mix, *g_ffn, *pool_w, *pool_scale, *g_kv, *w_k, *w_v, *w_q, *w_o, *sinks,
        *w_gr, *b_gr, *w_er, *b_er, *w_eg, *w_eu, *w_ed, *g_ple, *w_pg, *w_pu, *g_final;
    float* out; unsigned char* ws;
};

#define XB_TMO      128
#define XB_XCNT(j)  (256  + 64 * (j))
#define XB_XSUB(j)  (1280 + 64 * (j))
#define XB_XGEN(j)  (2304 + 64 * (j))
#define XB_TOP      3328
#define XB_TOPGEN   3392
#define XCD_BAR_WORDS 3456
#define XB_SPIN_CAP (1u << 18)
__device__ __forceinline__ unsigned xb_ld(unsigned* p)              { return __hip_atomic_load(p, __ATOMIC_RELAXED, __HIP_MEMORY_SCOPE_AGENT); }
__device__ __forceinline__ unsigned xb_add(unsigned* p, unsigned v) { return __hip_atomic_fetch_add(p, v, __ATOMIC_RELAXED, __HIP_MEMORY_SCOPE_AGENT); }
__device__ __forceinline__ unsigned xb_xcc_id() { return (unsigned)__builtin_amdgcn_s_getreg((3 << 11) | 20) & 0xFu; }
#define XB_SPIN(cond, bar) do { unsigned _sp = 0; while (cond) { __builtin_amdgcn_s_sleep(1); \
    if ((++_sp & 255u) == 0u) { if (xb_ld(&(bar)[XB_TMO])) break; if (_sp > XB_SPIN_CAP) { atomicAdd(&(bar)[XB_TMO], 1u); break; } } } } while (0)
struct XcdBarrier { unsigned* bar; unsigned x; volatile LAS unsigned* st; };
__device__ __forceinline__ XcdBarrier xcd_barrier_post(unsigned* bar, volatile LAS unsigned* st) {
    XcdBarrier b; b.bar = bar; b.x = xb_xcc_id(); b.st = st;
    if (threadIdx.x == 0) (void)xb_add(&bar[XB_XCNT(b.x)], 1u);
    return b;
}
__device__ __forceinline__ void xcd_barrier_complete(unsigned* bar, unsigned x, unsigned& nloc, unsigned& nx) {
    const unsigned G = gridDim.x * gridDim.y * gridDim.z;
    unsigned sum, cnt, mine, sp = 0u;
    for (;;) {
        sum = 0u; cnt = 0u; mine = 0u;
#pragma unroll
        for (unsigned j = 0; j < 16; ++j) { const unsigned c = xb_ld(&bar[XB_XCNT(j)]); sum += c; cnt += (c > 0u) ? 1u : 0u; mine = (j == x) ? c : mine; }
        if (sum == G) break;
        __builtin_amdgcn_s_sleep(1);
        if ((++sp & 255u) == 0u) { if (xb_ld(&bar[XB_TMO])) break; if (sp > XB_SPIN_CAP) { atomicAdd(&bar[XB_TMO], 1u); break; } }
    }
    nloc = mine > 0u ? mine : 1u; nx = cnt > 0u ? cnt : 1u;
}
__device__ __forceinline__ void xcd_barrier(const XcdBarrier& b) {
    asm volatile("s_waitcnt vmcnt(0)" ::: "memory");
    __syncthreads();
    if (threadIdx.x == 0) {
        unsigned* bar = b.bar;
        __builtin_amdgcn_s_waitcnt(0);
        unsigned nloc = b.st[0], nx = b.st[1];
        if (nloc == 0u) { xcd_barrier_complete(bar, b.x, nloc, nx); b.st[0] = nloc; b.st[1] = nx; }
        const unsigned old = xb_add(&bar[XB_XSUB(b.x)], 1u);
        const unsigned gen = old / nloc;
        if (old + 1u == (gen + 1u) * nloc) {
            __builtin_amdgcn_fence(__ATOMIC_RELEASE, "agent");
            asm volatile("s_waitcnt vmcnt(0)" ::: "memory");
            const unsigned og = xb_add(&bar[XB_TOP], 1u);
            const unsigned tg = og / nx;
            if (og + 1u == (tg + 1u) * nx) xb_add(&bar[XB_TOPGEN], 1u);
            else XB_SPIN(xb_ld(&bar[XB_TOPGEN]) == tg, bar);
            __builtin_amdgcn_fence(__ATOMIC_ACQUIRE, "agent");
            xb_add(&bar[XB_XGEN(b.x)], 1u);
            asm volatile("s_waitcnt vmcnt(0)" ::: "memory");
        } else {
            XB_SPIN(xb_ld(&bar[XB_XGEN(b.x)]) == gen, bar);
            __builtin_amdgcn_fence(__ATOMIC_ACQUIRE, "agent");
            asm volatile("s_waitcnt vmcnt(0)" ::: "memory");
        }
    }
    __syncthreads();
}

constexpr int RING_BYTES = 131072;
constexpr int MISC_OFF = RING_BYTES;
constexpr int TT_OFF = RING_BYTES + 256;
constexpr int LDS_BYTES = 147456;

namespace g8 {
constexpr int BM = 256, BK = 64, HALF = 128, HTB = HALF * BK * 2, NXCD = 8, WGM = 8;
__device__ __forceinline__ int lds_byte(int r, int c) { const int st = (r >> 4) * 2 + (c >> 5), rr = r & 15, cc = c & 31, ob = rr * 64 + cc * 2; return st * 1024 + (ob ^ (((ob >> 9) & 1) << 5)); }
__device__ __forceinline__ void stage_rc(int b, int& R, int& C) { const int st = b / 1024, sb = b % 1024, swz = sb ^ (((sb >> 9) & 1) << 5); R = (st >> 1) * 16 + swz / 64; C = (st & 1) * 32 + (swz % 64) / 2; }
__device__ __forceinline__ int perm32(int rho) { const int n = rho >> 4, i = rho & 15; return 8 * (i >> 2) + 4 * n + (i & 3); }
__device__ __forceinline__ int xcd_remap(int L, int nwg) { const int q = nwg / NXCD, r = nwg % NXCD, xcd = L % NXCD, off = L / NXCD; return (xcd < r ? xcd * (q + 1) : r * (q + 1) + (xcd - r) * q) + off; }
__device__ __forceinline__ bool dense_unit(int i, int G, int c, int nM, int nN, int& pm, int& pn) {
    const int nwg = nM * nN; const long L = (long)i * G + c; if (L >= nwg) return false;
    const int wgid = xcd_remap((int)L, nwg);
    const int nig = WGM * nN, gid = wgid / nig, fm = gid * WGM, gsz = (nM - fm) < WGM ? (nM - fm) : WGM;
    pm = fm + ((wgid % nig) % gsz); pn = (wgid % nig) / gsz; return true;
}

template <class Job>
__device__ __forceinline__ void gemm_phase(LAS unsigned char* lds, Job& J) {
    typedef typename Job::Unit Unit;
    constexpr int K = Job::K, nt = K / BK;
    static_assert(nt >= 4 && (nt % 2) == 0, "K must be a multiple of 128, >= 256");
    const int tid = threadIdx.x, wid = __builtin_amdgcn_readfirstlane(tid >> 6), lane = tid & 63, wr = wid >> 2, wc = wid & 3, fr = lane & 15, fq = lane >> 4;
    unsigned voffB[2];
#pragma unroll
    for (int i = 0; i < 2; ++i) { int R, C; stage_rc(tid * 16 + i * 8192, R, C); const int Rb = Job::PERM ? ((R & ~31) + perm32(R & 31)) : R; voffB[i] = (unsigned)(Rb * K + C) * 2u; }
    constexpr size_t kstep = (size_t)(BK * 2);
    constexpr size_t hstepB = (size_t)HALF * K * 2;
    const unsigned ldsw = (unsigned)wid * 1024u;
    const int aoff = lds_byte(wr * 64 + fr, fq * 8), boff = lds_byte(wc * 32 + fr, fq * 8);
#define G8_SA(b, h) (((b) * 2 + (h)) * HTB)
#define G8_SB(b, h) ((4 + (b) * 2 + (h)) * HTB)
#define G8_STAGE_B(bufoff, gbase) do { _Pragma("unroll") for (int _i = 0; _i < 2; ++_i) \
        __builtin_amdgcn_global_load_lds((const unsigned*)((const char*)(gbase) + voffB[_i]), (LAS unsigned*)(lds + (bufoff) + ldsw + _i * 8192), 16, 0, 0); } while (0)
#define G8_STAGE_A(bufoff, gbase, off2) do { _Pragma("unroll") for (int _i = 0; _i < 2; ++_i) \
        __builtin_amdgcn_global_load_lds((const unsigned*)((const char*)(gbase) + (off2)[_i]), (LAS unsigned*)(lds + (bufoff) + ldsw + _i * 8192), 16, 0, 0); } while (0)
#define G8_LDA(dst, b, h) do { _Pragma("unroll") for (int m = 0; m < 4; ++m) _Pragma("unroll") for (int k = 0; k < 2; ++k) dst[m][k] = *(const LAS bf16x8*)(lds + G8_SA(b, h) + aoff + m * 2048 + k * 1024); } while (0)
#define G8_LDB(dst, b, h) do { _Pragma("unroll") for (int n = 0; n < 2; ++n) _Pragma("unroll") for (int k = 0; k < 2; ++k) dst[n][k] = *(const LAS bf16x8*)(lds + G8_SB(b, h) + boff + n * 2048 + k * 1024); } while (0)
#define G8_MMA(ai, bj, At, Bt) do { __builtin_amdgcn_s_setprio(1); _Pragma("unroll") for (int m = 0; m < 4; ++m) _Pragma("unroll") for (int n = 0; n < 2; ++n) _Pragma("unroll") for (int k = 0; k < 2; ++k) \
        acc[ai][bj][m][n] = __builtin_amdgcn_mfma_f32_16x16x32_bf16(Bt[n][k], At[m][k], acc[ai][bj][m][n], 0, 0, 0); __builtin_amdgcn_s_setprio(0); } while (0)
#define G8_WAIT_V(n) asm volatile("s_waitcnt vmcnt(" #n ")" ::: "memory")
#define G8_WAIT_L(n) asm volatile("s_waitcnt lgkmcnt(" #n ")" ::: "memory")
#define G8_BAR __builtin_amdgcn_s_barrier()
#define G8_SCHED __builtin_amdgcn_sched_barrier(0)
    Unit cur, nxt; int ui = 0;
    if (!J.next(0, cur)) return;
    unsigned ao[2][2], no[2][2];
    { int tid_ = tid; asm volatile("" : "+v"(tid_)); J.a_offs(cur, tid_, ao); }
    f32x4 acc[2][2][4][2];
#pragma unroll
    for (int a = 0; a < 2; ++a)
#pragma unroll
        for (int b = 0; b < 2; ++b)
#pragma unroll
            for (int m = 0; m < 4; ++m)
#pragma unroll
                for (int n = 0; n < 2; ++n) acc[a][b][m][n] = (f32x4){0.f, 0.f, 0.f, 0.f};
    bf16x8 At[4][2], B0[2][2], B1[2][2];
    const char* cA = J.a_base(cur); const char* cB = J.b_base(cur);
    G8_STAGE_B(G8_SB(0, 0), cB); G8_STAGE_B(G8_SB(0, 1), cB + hstepB); G8_STAGE_A(G8_SA(0, 0), cA, ao[0]); G8_STAGE_A(G8_SA(0, 1), cA, ao[1]);
    if (wr == 1) G8_BAR;
    G8_WAIT_V(2); G8_BAR;
    G8_STAGE_B(G8_SB(1, 0), cB + kstep); G8_STAGE_A(G8_SA(1, 0), cA + kstep, ao[0]); G8_STAGE_B(G8_SB(1, 1), cB + hstepB + kstep);
    G8_WAIT_V(6); G8_BAR;
    for (;;) {
        const bool has_next = J.next(ui + 1, nxt);
        const char* nA = cA; const char* nB = cB;
#pragma unroll
        for (int h = 0; h < 2; ++h)
#pragma unroll
            for (int i = 0; i < 2; ++i) no[h][i] = ao[h][i];
        if (has_next) { nA = J.a_base(nxt); nB = J.b_base(nxt); int tid_ = tid; asm volatile("" : "+v"(tid_)); J.a_offs(nxt, tid_, no); }
#pragma unroll 1
        for (int t = 0; t < nt; t += 2) {
            const bool last = (t == nt - 2);
            const char* a1 = cA + (size_t)(t + 1) * kstep;
            const char* a2 = last ? nA : cA + (size_t)(t + 2) * kstep; const char* b2 = last ? nB : cB + (size_t)(t + 2) * kstep;
            const char* a3 = a2 + kstep; const char* b3 = b2 + kstep;
            unsigned o2[2][2];
#pragma unroll
            for (int h = 0; h < 2; ++h)
#pragma unroll
                for (int i = 0; i < 2; ++i) o2[h][i] = last ? no[h][i] : ao[h][i];
            G8_LDB(B0, 0, 0); G8_LDB(B1, 0, 1); G8_SCHED; G8_LDA(At, 0, 0); G8_STAGE_A(G8_SA(1, 1), a1, ao[1]);
            G8_WAIT_V(8); G8_WAIT_L(0); G8_BAR; G8_MMA(0, 0, At, B0); G8_MMA(0, 1, At, B1); G8_BAR; G8_SCHED;
            G8_LDA(At, 0, 1); G8_STAGE_B(G8_SB(0, 0), b2); G8_STAGE_B(G8_SB(0, 1), b2 + hstepB); G8_STAGE_A(G8_SA(0, 0), a2, o2[0]);
            G8_WAIT_V(8); G8_WAIT_L(0); G8_BAR; G8_MMA(1, 0, At, B0); G8_MMA(1, 1, At, B1); G8_BAR; G8_SCHED;
            G8_LDB(B0, 1, 0); G8_LDB(B1, 1, 1); G8_SCHED; G8_LDA(At, 1, 0); G8_STAGE_A(G8_SA(0, 1), a2, o2[1]);
            G8_WAIT_V(8); G8_WAIT_L(0); G8_BAR; G8_MMA(0, 0, At, B0); G8_MMA(0, 1, At, B1); G8_BAR; G8_SCHED;
            G8_LDA(At, 1, 1); G8_STAGE_B(G8_SB(1, 0), b3); G8_STAGE_B(G8_SB(1, 1), b3 + hstepB); G8_STAGE_A(G8_SA(1, 0), a3, o2[0]);
            G8_WAIT_V(8); G8_WAIT_L(0); G8_BAR; G8_MMA(1, 0, At, B0); G8_MMA(1, 1, At, B1); G8_BAR; G8_SCHED;
        }
        if (wr == 0) G8_BAR;
        { int fr_ = fr, fq_ = fq; asm volatile("" : "+v"(fr_), "+v"(fq_)); J.epi(acc, cur, wr, wc, fr_, fq_); }
        if (!has_next) break;
#pragma unroll
        for (int a = 0; a < 2; ++a)
#pragma unroll
            for (int b = 0; b < 2; ++b)
#pragma unroll
                for (int m = 0; m < 4; ++m)
#pragma unroll
                    for (int n = 0; n < 2; ++n) acc[a][b][m][n] = (f32x4){0.f, 0.f, 0.f, 0.f};
        cur = nxt; cA = nA; cB = nB; ++ui;
#pragma unroll
        for (int h = 0; h < 2; ++h)
#pragma unroll
            for (int i = 0; i < 2; ++i) ao[h][i] = no[h][i];
        if (wr == 1) G8_BAR;
    }
    G8_WAIT_V(0);
    G8_BAR;
#undef G8_SA
#undef G8_SB
#undef G8_STAGE_A
#undef G8_STAGE_B
#undef G8_LDA
#undef G8_LDB
#undef G8_MMA
#undef G8_WAIT_V
#undef G8_WAIT_L
#undef G8_BAR
#undef G8_SCHED
}
}
struct JobBase { Ptrs P; int G, c; };

__device__ __forceinline__ void dense_offs(int lda, int tid, unsigned (&o)[2][2]) {
#pragma unroll
    for (int i = 0; i < 2; ++i) { int R, C; g8::stage_rc(tid * 16 + i * 8192, R, C);
#pragma unroll
        for (int h = 0; h < 2; ++h) o[h][i] = (unsigned)((h * 128 + R) * lda + C) * 2u; }
}

struct JobPool : JobBase {
    static constexpr int K = 256; static constexpr bool PERM = false;
    struct Unit { int pm, pn; };
    __device__ __forceinline__ bool next(int i, Unit& u) const { return g8::dense_unit(i, G, c, T / 256, 4, u.pm, u.pn); }
    __device__ __forceinline__ const char* a_base(const Unit& u) const { return (const char*)(P.ws + WS_D16) + ((size_t)u.pm * 256 * D + u.pn * 256) * 2; }
    __device__ __forceinline__ const char* b_base(const Unit& u) const { return (const char*)(P.ws + WS_W + WW_POOL) + (size_t)u.pn * 256 * 256 * 2; }
    __device__ __forceinline__ void a_offs(const Unit&, int tid, unsigned (&o)[2][2]) const { dense_offs(D, tid, o); }
    __device__ __forceinline__ void epi(const f32x4 (&acc)[2][2][4][2], const Unit& u, int wr, int wc, int fr, int fq) const {
        const int row0 = u.pm * 256 + wr * 64 + fr, col0 = u.pn * 256 + wc * 32 + 4 * fq;
#pragma unroll
        for (int ai = 0; ai < 2; ++ai) {
            f32x4 xv[4][2][2];
#pragma unroll
            for (int m = 0; m < 4; ++m) { const size_t ro = (size_t)(row0 + ai * 128 + m * 16) * D + col0;
#pragma unroll
                for (int bj = 0; bj < 2; ++bj)
#pragma unroll
                    for (int n = 0; n < 2; ++n) xv[m][bj][n] = __builtin_nontemporal_load((const f32x4*)(P.x + ro + bj * 128 + n * 16)); }
#pragma unroll
            for (int m = 0; m < 4; ++m) { const size_t ro = (size_t)(row0 + ai * 128 + m * 16) * D + col0;
#pragma unroll
                for (int bj = 0; bj < 2; ++bj)
#pragma unroll
                    for (int n = 0; n < 2; ++n) *(f32x4*)(P.out + ro + bj * 128 + n * 16) = xv[m][bj][n] + acc[ai][bj][m][n]; }
        }
    }
};
struct JobUp : JobBase {
    static constexpr int K = 256; static constexpr bool PERM = true;
    struct Unit { int l, pm, pn; };
    __device__ __forceinline__ bool next(int i, Unit& u) const { int pm2; if (!g8::dense_unit(i, G, c, 2 * T / 256, 4, pm2, u.pn)) return false; u.l = pm2 >> 6; u.pm = pm2 & 63; return true; }
    __device__ __forceinline__ const char* a_base(const Unit& u) const { return (const char*)(P.ws + WS_P16) + ((size_t)u.l * T + (size_t)u.pm * 256) * PD * 2; }
    __device__ __forceinline__ const char* b_base(const Unit& u) const { return (const char*)(P.ws + WS_W + WW_PLEU) + ((size_t)u.l * D + (size_t)u.pn * 256) * PD * 2; }
    __device__ __forceinline__ void a_offs(const Unit&, int tid, unsigned (&o)[2][2]) const { dense_offs(PD, tid, o); }
    __device__ __forceinline__ void epi(const f32x4 (&acc)[2][2][4][2], const Unit& u, int wr, int wc, int fr, int fq) const {
        bf16_t* Ub = (bf16_t*)(P.ws + WS_U) + (size_t)u.l * T * D;
        const int row0 = u.pm * 256 + wr * 64 + fr, col0 = u.pn * 256 + wc * 32 + 8 * fq;
#pragma unroll
        for (int ai = 0; ai < 2; ++ai)
#pragma unroll
            for (int m = 0; m < 4; ++m) { bf16_t* rowp = Ub + (size_t)(row0 + ai * 128 + m * 16) * D + col0;
#pragma unroll
                for (int bj = 0; bj < 2; ++bj) { const f32x4 v0 = acc[ai][bj][m][0], v1 = acc[ai][bj][m][1];
                    u32x4 w; w.x = cvt_pk_bf16(v0[0], v0[1]); w.y = cvt_pk_bf16(v0[2], v0[3]); w.z = cvt_pk_bf16(v1[0], v1[1]); w.w = cvt_pk_bf16(v1[2], v1[3]);
                    *(u32x4*)(rowp + bj * 128) = w; } }
    }
};
__device__ __forceinline__ void build_tile_table(const Ptrs& P, int l, LAS int* tt) {
    const unsigned* cnt = (const unsigned*)(P.ws + WS_CTL) + CW_CNT + 64 * l;
    const int t = threadIdx.x;
    if (t < 161) {
        int tb = 0, lb = -1, nv = 0;
        for (int e = 0; e < NE; ++e) { const int ce = (int)cnt[e], ntl = (ce + 255) >> 8;
            if (t < 160 && t >= tb && t < tb + ntl) { const int j = t - tb; lb = e * T + 256 * j; nv = ce - 256 * j; if (nv > 256) nv = 256; }
            tb += ntl; }
        if (t == 160) tt[0] = tb; else { tt[1 + 2 * t] = lb; tt[2 + 2 * t] = nv; }
    }
    __syncthreads();
}
struct MoeUnit { int tile, pn, lb, nv; };
__device__ __forceinline__ bool moe_unit(int i, int G, int c, const LAS int* tt, MoeUnit& u) {
    const int ntiles = __builtin_amdgcn_readfirstlane(tt[0]); const int nwg = ntiles * 4;
    const long L = (long)i * G + c; if (L >= nwg) return false;
    const int v = g8::xcd_remap((int)L, nwg);
    u.tile = v >> 2; u.pn = v & 3; u.lb = __builtin_amdgcn_readfirstlane(tt[1 + 2 * u.tile]); u.nv = __builtin_amdgcn_readfirstlane(tt[2 + 2 * u.tile]); return true;
}
struct JobGateUp : JobBase {
    static constexpr int K = 1024; static constexpr bool PERM = true;
    typedef MoeUnit Unit;
    int l; const bf16_t* hb; const LAS int* tt;
    __device__ __forceinline__ bool next(int i, Unit& u) const { return moe_unit(i, G, c, tt, u); }
    __device__ __forceinline__ const char* a_base(const Unit&) const { return (const char*)hb; }
    __device__ __forceinline__ const char* b_base(const Unit& u) const { const int e = u.lb >> 14; return (const char*)(P.ws + WS_W + WW_GU) + (((size_t)l * NE + e) * 1024 + (size_t)u.pn * 256) * 1024 * 2; }
    __device__ __forceinline__ void a_offs(const Unit& u, int tid, unsigned (&o)[2][2]) const {
        const unsigned* list = (const unsigned*)(P.ws + WS_LIST) + u.lb;
#pragma unroll
        for (int i = 0; i < 2; ++i) { int R, C; g8::stage_rc(tid * 16 + i * 8192, R, C);
#pragma unroll
            for (int h = 0; h < 2; ++h) { int rt = h * 128 + R; rt = rt < u.nv ? rt : u.nv - 1; const unsigned en = list[rt]; o[h][i] = (en >> 1) * (unsigned)(D * 2) + (unsigned)C * 2u; } }
    }
    __device__ __forceinline__ void epi(const f32x4 (&acc)[2][2][4][2], const Unit& u, int wr, int wc, int fr, int fq) const {
        const unsigned* list = (const unsigned*)(P.ws + WS_LIST) + u.lb; const float* rr = (const float*)(P.ws + WS_RX) + T; const float* gwv = (const float*)(P.ws + WS_RX) + 2 * T;
        bf16_t* act = (bf16_t*)(P.ws + WS_ACT) + (size_t)u.tile * 256 * DE + u.pn * 128 + wc * 32 + 8 * fq;
        unsigned en[2][4]; float rv[2][4], gv[2][4];
#pragma unroll
        for (int ai = 0; ai < 2; ++ai)
#pragma unroll
            for (int m = 0; m < 4; ++m) { const int rt = ai * 128 + wr * 64 + m * 16 + fr; const int rc = rt < u.nv ? rt : u.nv - 1; en[ai][m] = list[rc]; }
#pragma unroll
        for (int ai = 0; ai < 2; ++ai)
#pragma unroll
            for (int m = 0; m < 4; ++m) { rv[ai][m] = rr[en[ai][m] >> 1]; gv[ai][m] = gwv[en[ai][m]]; }
#pragma unroll
        for (int ai = 0; ai < 2; ++ai)
#pragma unroll
            for (int m = 0; m < 4; ++m) { const int rt = ai * 128 + wr * 64 + m * 16 + fr; const float r = rv[ai][m], gw = gv[ai][m];
                float o[8];
#pragma unroll
                for (int n = 0; n < 2; ++n)
#pragma unroll
                    for (int j = 0; j < 4; ++j) { const float g = acc[ai][0][m][n][j] * r, up = acc[ai][1][m][n][j] * r; o[n * 4 + j] = gw * g * fast_sigmoid(g) * up; }
                u32x4 w; w.x = cvt_pk_bf16(o[0], o[1]); w.y = cvt_pk_bf16(o[2], o[3]); w.z = cvt_pk_bf16(o[4], o[5]); w.w = cvt_pk_bf16(o[6], o[7]);
                *(u32x4*)(act + (size_t)rt * DE) = w; }
    }
};
struct JobDown : JobBase {
    static constexpr int K = 512; static constexpr bool PERM = true;
    typedef MoeUnit Unit;
    int l; const LAS int* tt;
    __device__ __forceinline__ bool next(int i, Unit& u) const { return moe_unit(i, G, c, tt, u); }
    __device__ __forceinline__ const char* a_base(const Unit& u) const { return (const char*)(P.ws + WS_ACT) + (size_t)u.tile * 256 * DE * 2; }
    __device__ __forceinline__ const char* b_base(const Unit& u) const { const int e = u.lb >> 14; return (const char*)(P.ws + WS_W + WW_DN) + (((size_t)l * NE + e) * 1024 + (size_t)u.pn * 256) * DE * 2; }
    __device__ __forceinline__ void a_offs(const Unit&, int tid, unsigned (&o)[2][2]) const { dense_offs(DE, tid, o); }
    __device__ __forceinline__ void epi(const f32x4 (&acc)[2][2][4][2], const Unit& u, int wr, int wc, int fr, int fq) const {
        const unsigned* list = (const unsigned*)(P.ws + WS_LIST) + u.lb;
        bf16_t* Y = (bf16_t*)(P.ws + WS_Y) + u.pn * 256 + wc * 32 + 8 * fq;
        unsigned en[2][4];
#pragma unroll
        for (int ai = 0; ai < 2; ++ai)
#pragma unroll
            for (int m = 0; m < 4; ++m) { const int rt = ai * 128 + wr * 64 + m * 16 + fr; en[ai][m] = list[rt < u.nv ? rt : u.nv - 1]; }
#pragma unroll
        for (int ai = 0; ai < 2; ++ai)
#pragma unroll
            for (int m = 0; m < 4; ++m) { const int rt = ai * 128 + wr * 64 + m * 16 + fr;
                if (rt < u.nv) { bf16_t* rowp = Y + (size_t)en[ai][m] * D;
#pragma unroll
                    for (int bj = 0; bj < 2; ++bj) { const f32x4 v0 = acc[ai][bj][m][0], v1 = acc[ai][bj][m][1];
                        u32x4 w; w.x = cvt_pk_bf16(v0[0], v0[1]); w.y = cvt_pk_bf16(v0[2], v0[3]); w.z = cvt_pk_bf16(v1[0], v1[1]); w.w = cvt_pk_bf16(v1[2], v1[3]);
                        *(u32x4*)(rowp + bj * 128) = w; } } }
    }
};
struct JobPle : JobBase {
    static constexpr int K = 1024; static constexpr bool PERM = false;
    struct Unit { int pm, pn; };
    int l; const bf16_t* hbn; bf16_t* hb3; float* hdst; float* ss3;
    __device__ __forceinline__ bool next(int i, Unit& u) const { return g8::dense_unit(i, G, c, T / 256, 4, u.pm, u.pn); }
    __device__ __forceinline__ const char* a_base(const Unit& u) const { return (const char*)hbn + (size_t)u.pm * 256 * D * 2; }
    __device__ __forceinline__ const char* b_base(const Unit& u) const { return (const char*)(P.ws + WS_W + WW_PLEG) + ((size_t)l * D + (size_t)u.pn * 256) * D * 2; }
    __device__ __forceinline__ void a_offs(const Unit&, int tid, unsigned (&o)[2][2]) const { dense_offs(D, tid, o); }
    __device__ __forceinline__ void epi(const f32x4 (&acc)[2][2][4][2], const Unit& u, int wr, int wc, int fr, int fq) const {
        const bf16_t* Ub = (const bf16_t*)(P.ws + WS_U) + (size_t)l * T * D;
        const int row0 = u.pm * 256 + wr * 64 + fr, col0 = u.pn * 256 + wc * 32 + 4 * fq;
#pragma unroll
        for (int ai = 0; ai < 2; ++ai)
#pragma unroll
            for (int mp = 0; mp < 2; ++mp) {
                f32x4 hv[2][2][2]; u32x2 uv[2][2][2];
#pragma unroll
                for (int mm = 0; mm < 2; ++mm) { const size_t ro = (size_t)(row0 + ai * 128 + (2 * mp + mm) * 16) * D + col0;
#pragma unroll
                    for (int bj = 0; bj < 2; ++bj)
#pragma unroll
                        for (int n = 0; n < 2; ++n) { const size_t o = ro + bj * 128 + n * 16; hv[mm][bj][n] = *(const f32x4*)(P.out + o); uv[mm][bj][n] = *(const u32x2*)(Ub + o); } }
#pragma unroll
                for (int mm = 0; mm < 2; ++mm) { const int m = 2 * mp + mm; const int row = row0 + ai * 128 + m * 16; const size_t ro = (size_t)row * D + col0; float ss = 0.f;
#pragma unroll
                    for (int bj = 0; bj < 2; ++bj)
#pragma unroll
                        for (int n = 0; n < 2; ++n) { const size_t o = ro + bj * 128 + n * 16; const f32x4 h0 = hv[mm][bj][n]; const u32x2 uu = uv[mm][bj][n];
                            const f32x4 g = acc[ai][bj][m][n]; f32x4 hn;
                            hn[0] = h0[0] + fast_sigmoid(g[0]) * __uint_as_float(uu.x << 16); hn[1] = h0[1] + fast_sigmoid(g[1]) * __uint_as_float(uu.x & 0xffff0000u);
                            hn[2] = h0[2] + fast_sigmoid(g[2]) * __uint_as_float(uu.y << 16); hn[3] = h0[3] + fast_sigmoid(g[3]) * __uint_as_float(uu.y & 0xffff0000u);
                            *(f32x4*)(hdst + o) = hn;
                            if (hb3) { u32x2 w; w.x = cvt_pk_bf16(hn[0], hn[1]); w.y = cvt_pk_bf16(hn[2], hn[3]); *(u32x2*)(hb3 + o) = w; ss += (hn[0] * hn[0] + hn[1] * hn[1]) + (hn[2] * hn[2] + hn[3] * hn[3]); } }
                    if (hb3) { ss += __shfl_xor(ss, 16); ss += __shfl_xor(ss, 32); if (fq == 0) atomicAdd(ss3 + row, ss); } }
            }
    }
};
struct JobKvq : JobBase {
    static constexpr int K = 1024; static constexpr bool PERM = true;
    struct Unit { int pm, pn; };
    const bf16_t* hb3;
    __device__ __forceinline__ bool next(int i, Unit& u) const { return g8::dense_unit(i, G, c, T / 256, 6, u.pm, u.pn); }
    __device__ __forceinline__ const char* a_base(const Unit& u) const { return (const char*)hb3 + (size_t)u.pm * 256 * D * 2; }
    __device__ __forceinline__ const char* b_base(const Unit& u) const { return (const char*)(P.ws + WS_W + WW_KVQ) + (size_t)u.pn * 256 * D * 2; }
    __device__ __forceinline__ void a_offs(const Unit&, int tid, unsigned (&o)[2][2]) const { dense_offs(D, tid, o); }
    __device__ __forceinline__ void epi(const f32x4 (&acc)[2][2][4][2], const Unit& u, int wr, int wc, int fr, int fq) const {
        const float* ss3 = (const float*)(P.ws + WS_CTL) + CW_SS3; const float* cs = (const float*)(P.ws + WS_CS);
        const int row0 = u.pm * 256 + wr * 64 + fr, cw = wc * 32 + 8 * fq;
        bf16_t* dst; int ldd; float sc = 1.f;
        if (u.pn == 0) { dst = (bf16_t*)(P.ws + WS_K); ldd = KD; } else if (u.pn == 1) { dst = (bf16_t*)(P.ws + WS_V); ldd = KD; } else { dst = (bf16_t*)(P.ws + WS_Q) + (u.pn - 2) * 256; ldd = D; sc = QSCALE; }
        const bool rope = (u.pn != 1);
        float rv[2][4];
#pragma unroll
        for (int ai = 0; ai < 2; ++ai)
#pragma unroll
            for (int m = 0; m < 4; ++m) rv[ai][m] = ss3[row0 + ai * 128 + m * 16];
#pragma unroll
        for (int ai = 0; ai < 2; ++ai)
#pragma unroll
            for (int mp = 0; mp < 2; ++mp) {
                f32x4 cv[2][2][2];
                if (rope) {
#pragma unroll
                    for (int mm = 0; mm < 2; ++mm) { const int row = row0 + ai * 128 + (2 * mp + mm) * 16;
#pragma unroll
                        for (int bj = 0; bj < 2; ++bj) { const int pi = ((bj * 128 + cw) & 63) >> 1; cv[mm][bj][0] = *(const f32x4*)(cs + (size_t)row * 64 + pi * 2); cv[mm][bj][1] = *(const f32x4*)(cs + (size_t)row * 64 + pi * 2 + 4); } }
                }
#pragma unroll
                for (int mm = 0; mm < 2; ++mm) { const int m = 2 * mp + mm; const int row = row0 + ai * 128 + m * 16; const float r = __builtin_amdgcn_rsqf(rv[ai][m] * (1.f / D) + EPS) * sc;
#pragma unroll
                    for (int bj = 0; bj < 2; ++bj) { f32x4 v0 = acc[ai][bj][m][0] * r, v1 = acc[ai][bj][m][1] * r; const int cc = bj * 128 + cw;
                        if (rope) { const f32x4 c0 = cv[mm][bj][0], c1 = cv[mm][bj][1];
                            f32x4 w0, w1;
                            w0[0] = v0[0] * c0[0] - v0[1] * c0[1]; w0[1] = v0[1] * c0[0] + v0[0] * c0[1]; w0[2] = v0[2] * c0[2] - v0[3] * c0[3]; w0[3] = v0[3] * c0[2] + v0[2] * c0[3];
                            w1[0] = v1[0] * c1[0] - v1[1] * c1[1]; w1[1] = v1[1] * c1[0] + v1[0] * c1[1]; w1[2] = v1[2] * c1[2] - v1[3] * c1[3]; w1[3] = v1[3] * c1[2] + v1[2] * c1[3];
                            v0 = w0; v1 = w1; }
                        u32x4 w; w.x = cvt_pk_bf16(v0[0], v0[1]); w.y = cvt_pk_bf16(v0[2], v0[3]); w.z = cvt_pk_bf16(v1[0], v1[1]); w.w = cvt_pk_bf16(v1[2], v1[3]);
                        *(u32x4*)(dst + (size_t)row * ldd + cc) = w; } }
            }
    }
};
struct JobOproj : JobBase {
    static constexpr int K = 1024; static constexpr bool PERM = false;
    struct Unit { int pm, pn; };
    float* hdst;
    __device__ __forceinline__ bool next(int i, Unit& u) const { return g8::dense_unit(i, G, c, T / 256, 4, u.pm, u.pn); }
    __device__ __forceinline__ const char* a_base(const Unit& u) const { return (const char*)(P.ws + WS_O) + (size_t)u.pm * 256 * D * 2; }
    __device__ __forceinline__ const char* b_base(const Unit& u) const { return (const char*)(P.ws + WS_W + WW_WO) + (size_t)u.pn * 256 * D * 2; }
    __device__ __forceinline__ void a_offs(const Unit&, int tid, unsigned (&o)[2][2]) const { dense_offs(D, tid, o); }
    __device__ __forceinline__ void epi(const f32x4 (&acc)[2][2][4][2], const Unit& u, int wr, int wc, int fr, int fq) const {
        const int row0 = u.pm * 256 + wr * 64 + fr, col0 = u.pn * 256 + wc * 32 + 4 * fq;
#pragma unroll
        for (int ai = 0; ai < 2; ++ai) {
            f32x4 hv[4][2][2];
#pragma unroll
            for (int m = 0; m < 4; ++m) { const size_t ro = (size_t)(row0 + ai * 128 + m * 16) * D + col0;
#pragma unroll
                for (int bj = 0; bj < 2; ++bj)
#pragma unroll
                    for (int n = 0; n < 2; ++n) hv[m][bj][n] = *(const f32x4*)(P.out + ro + bj * 128 + n * 16); }
#pragma unroll
            for (int m = 0; m < 4; ++m) { const size_t ro = (size_t)(row0 + ai * 128 + m * 16) * D + col0;
#pragma unroll
                for (int bj = 0; bj < 2; ++bj)
#pragma unroll
                    for (int n = 0; n < 2; ++n) *(f32x4*)(hdst + ro + bj * 128 + n * 16) = hv[m][bj][n] + acc[ai][bj][m][n]; }
        }
    }
};
__device__ __forceinline__ int tr_row(int mode, int roff, int n) {
    if (mode == 1) return roff + (n & ~63) + 2 * (n & 31) + ((n >> 5) & 1);
    if (mode == 2) return roff + (n >> 7) * 256 + (n & 127);
    return roff + n;
}
struct TrDesc { const float* W; int N; const float* ksc; const float* nsc; bf16_t* WT; int ldk, mode, roff, k0, n0; };
__device__ __forceinline__ void tr_load(const TrDesc& d, int lane, f32x4 (&v)[8]) {
    const int o = lane >> 3, q = lane & 7; const float* src = d.W + (size_t)(d.k0 + 8 * o) * d.N + d.n0 + 4 * q;
#pragma unroll
    for (int i = 0; i < 8; ++i) v[i] = __builtin_nontemporal_load((const f32x4*)(src + (size_t)i * d.N));
}
__device__ __forceinline__ void tr_store(const TrDesc& d, int lane, const f32x4 (&v)[8]) {
    const int o = lane >> 3, q = lane & 7;
    f32x4 k0v = (f32x4){1.f, 1.f, 1.f, 1.f}, k1v = k0v, nsv = k0v;
    if (d.ksc) { k0v = *(const f32x4*)(d.ksc + d.k0 + 8 * o); k1v = *(const f32x4*)(d.ksc + d.k0 + 8 * o + 4); }
    if (d.nsc) nsv = *(const f32x4*)(d.nsc + d.n0 + 4 * q);
#pragma unroll
    for (int j = 0; j < 4; ++j) { const float ns = nsv[j];
        u32x4 w; w.x = cvt_pk_bf16(v[0][j] * k0v[0] * ns, v[1][j] * k0v[1] * ns); w.y = cvt_pk_bf16(v[2][j] * k0v[2] * ns, v[3][j] * k0v[3] * ns);
        w.z = cvt_pk_bf16(v[4][j] * k1v[0] * ns, v[5][j] * k1v[1] * ns); w.w = cvt_pk_bf16(v[6][j] * k1v[2] * ns, v[7][j] * k1v[3] * ns);
        *(u32x4*)(d.WT + (size_t)tr_row(d.mode, d.roff, d.n0 + 4 * q + j) * d.ldk + d.k0 + 8 * o) = w; }
}
constexpr int N_TR_EXP = 64 * 768, N_TR_SMALL = 2688, N_TR_ITEMS = N_TR_EXP + N_TR_SMALL;
__device__ __forceinline__ TrDesc tr_desc(const Ptrs& P, int it) {
    bf16_t* Wb = (bf16_t*)(P.ws + WS_W); TrDesc d;
    if (it < N_TR_EXP) {
        const int le = it / 768, r = it % 768, which = r >> 8, r2 = r & 255, l = le >> 5;
        if (which < 2) d = TrDesc{(which ? P.w_eu : P.w_eg) + (size_t)le * D * DE, DE, P.g_ffn + l * D, nullptr, Wb + WW_GU / 2 + (size_t)le * 1024 * 1024, 1024, 2, which * 128, (r2 >> 4) * 64, (r2 & 15) * 32};
        else d = TrDesc{P.w_ed + (size_t)le * DE * D, D, nullptr, nullptr, Wb + WW_DN / 2 + (size_t)le * 1024 * DE, DE, 0, 0, (r2 >> 5) * 64, (r2 & 31) * 32};
        return d;
    }
    int s = it - N_TR_EXP;
    if (s < 1024) { const int l = s >> 9, r = s & 511; return TrDesc{P.w_pg + (size_t)l * D * D, D, P.g_ple + l * D, nullptr, Wb + WW_PLEG / 2 + (size_t)l * D * D, D, 0, 0, (r >> 5) * 64, (r & 31) * 32}; }
    s -= 1024;
    if (s < 256) { const int l = s >> 7, r = s & 127; return TrDesc{P.w_pu + (size_t)l * PD * D, D, nullptr, nullptr, Wb + WW_PLEU / 2 + (size_t)l * D * PD, PD, 0, 0, (r >> 5) * 64, (r & 31) * 32}; }
    s -= 256;
    if (s < 128) return TrDesc{P.w_k, KD, P.g_kv, nullptr, Wb + WW_KVQ / 2, D, 1, 0, (s >> 3) * 64, (s & 7) * 32};
    s -= 128;
    if (s < 128) return TrDesc{P.w_v, KD, P.g_kv, nullptr, Wb + WW_KVQ / 2, D, 0, 256, (s >> 3) * 64, (s & 7) * 32};
    s -= 128;
    if (s < 512) return TrDesc{P.w_q, D, P.g_mix + D, nullptr, Wb + WW_KVQ / 2, D, 1, 512, (s >> 5) * 64, (s & 31) * 32};
    s -= 512;
    if (s < 512) return TrDesc{P.w_o, D, nullptr, nullptr, Wb + WW_WO / 2, D, 0, 0, (s >> 5) * 64, (s & 31) * 32};
    s -= 512;
    { const int g = s >> 5, r = s & 31; return TrDesc{P.pool_w + (size_t)g * 65536, 256, nullptr, P.pool_scale + g * 256, Wb + WW_POOL / 2 + (size_t)g * 65536, 256, 0, 0, (r >> 3) * 64, (r & 7) * 32}; }
}
template <int W> __device__ __forceinline__ void pooldiff_cols(const Ptrs& P, int t0, int s0, const LAS float* rr, int c) {
    const float2 g = *(const float2*)(P.g_mix + c);
    float2 ring[16];
#pragma unroll
    for (int i = 0; i < 16; ++i) ring[i] = make_float2(0.f, 0.f);
    bf16_t* dout = (bf16_t*)(P.ws + WS_D16);
    for (int blk = 0; blk < 5; ++blk) {
#pragma unroll
        for (int jj = 0; jj < 16; ++jj) {
            const int j = blk * 16 + jj - 16;
            const int s = s0 + j;
            float2 v = make_float2(0.f, 0.f);
            if (s >= 0) { const float2 xv = *(const float2*)(P.x + (size_t)(t0 + j) * D + c); const float r = rr[j + 16]; v.x = xv.x * r * g.x; v.y = xv.y * r * g.y; }
            ring[jj] = v;
            if (j >= 0) {
                float2 sum = make_float2(0.f, 0.f);
#pragma unroll
                for (int q = 0; q < W; ++q) { const float2 e = ring[(jj - q) & 15]; sum.x += e.x; sum.y += e.y; }
                const int cnt = (s + 1 < W) ? s + 1 : W; const float ic = 1.f / (float)cnt;
                *(unsigned*)(dout + (size_t)(t0 + j) * D + c) = cvt_pk_bf16(sum.x * ic - v.x, sum.y * ic - v.y);
            }
        }
    }
}
__device__ __forceinline__ void phase_prologue(const Ptrs& P, LAS unsigned char* lds, int vcu, int G) {
    const int tid = threadIdx.x, lane = tid & 63, wave = tid >> 6;
    const int gw = vcu * NWAVES + wave, NGW = G * NWAVES;
    for (int it = gw; it < N_TR_ITEMS; it += 2 * NGW) {
        const int it2 = it + NGW; const bool has2 = it2 < N_TR_ITEMS;
        const TrDesc d0 = tr_desc(P, it), d1 = tr_desc(P, has2 ? it2 : it);
        f32x4 v0[8], v1[8];
        tr_load(d0, lane, v0); tr_load(d1, lane, v1);
        tr_store(d0, lane, v0); if (has2) tr_store(d1, lane, v1);
    }
    const size_t gt = (size_t)blockIdx.x * NTHREADS + tid, GT = (size_t)G * NTHREADS;
    { float* wr = (float*)(P.ws + WS_W + WW_WR);
      for (size_t i = gt; i < (size_t)2 * 48 * D; i += GT) { const int k = (int)(i & 1023), n = (int)((i >> 10) % 48), l = (int)(i / (48 * 1024));
          float v = 0.f; if (n < 32) v = P.w_er[((size_t)l * D + k) * 32 + n]; else if (n < 36) v = P.w_gr[((size_t)l * D + k) * 4 + (n - 32)];
          wr[i] = v * P.g_ffn[l * D + k]; } }
    { float2* cs = (float2*)(P.ws + WS_CS);
      for (size_t i = gt; i < (size_t)T * 32; i += GT) { const int t = (int)(i >> 5), j = (int)(i & 31);
          const float inv = exp2f(-(float)j * (13.287712379549449f / 32.f));
          const float ang = (float)P.pos[t] * inv; const double rev = (double)ang * 0.15915494309189535; const float fr = (float)(rev - rint(rev));
          cs[i] = make_float2(__builtin_amdgcn_cosf(fr), __builtin_amdgcn_sinf(fr)); } }
    { bf16_t* p16 = (bf16_t*)(P.ws + WS_P16);
      for (size_t i = gt; i < (size_t)2 * T * PD / 4; i += GT) { const f32x4 v = *(const f32x4*)(P.p + 4 * i); u32x2 w; w.x = cvt_pk_bf16(v[0], v[1]); w.y = cvt_pk_bf16(v[2], v[3]); *(u32x2*)(p16 + 4 * i) = w; } }
    __syncthreads();
    LAS float* rr = (LAS float*)lds;
    for (int ch = blockIdx.x; ch < T / 64; ch += G) {
        const int t0 = ch * 64, s0 = t0 & (SEQ - 1);
        for (int j = wave; j < 80; j += NWAVES) { const int s = s0 + j - 16; float r = 0.f;
            if (s >= 0) { const f32x4* xr = (const f32x4*)(P.x + (size_t)(t0 + j - 16) * D) + lane; float a = 0.f;
#pragma unroll
                for (int q = 0; q < 4; ++q) { const f32x4 v = xr[64 * q]; a += (v[0] * v[0] + v[1] * v[1]) + (v[2] * v[2] + v[3] * v[3]); }
                r = __builtin_amdgcn_rsqf(wave_sum(a) * (1.f / D) + EPS); }
            if (lane == 0) rr[j] = r; }
        __syncthreads();
        const int c = 2 * tid;
        switch (wave >> 1) { case 0: pooldiff_cols<2>(P, t0, s0, rr, c); break; case 1: pooldiff_cols<4>(P, t0, s0, rr, c); break; case 2: pooldiff_cols<8>(P, t0, s0, rr, c); break; default: pooldiff_cols<16>(P, t0, s0, rr, c); break; }
        __syncthreads();
    }
}

typedef float mf4 __attribute__((ext_vector_type(4)));
__device__ __forceinline__ void phase_router(const Ptrs& P, int l, bf16_t* hb, unsigned* gcnt, unsigned* list, float* rout, LAS unsigned char* lds, int G) {
    const int tid = threadIdx.x, lane = tid & 63, wave = __builtin_amdgcn_readfirstlane(tid >> 6), tg = wave & 3, kh = wave >> 2, li = lane & 15, q = lane >> 4;
    LAS float* bbuf = (LAS float*)lds; LAS float* part = (LAS float*)(lds + 53248); LAS float* ssp = (LAS float*)(lds + 79872);
    LAS unsigned* lcnt = (LAS unsigned*)(lds + 80384); LAS unsigned* lbase = (LAS unsigned*)(lds + 80512);
    const float* wrT = (const float*)(P.ws + WS_W + WW_WR) + (size_t)l * 48 * D;
    float* gwv = rout + T;
    for (int item = blockIdx.x; item < T / 64; item += G) {
        const int row = item * 64 + tg * 16 + li;
        const float* hrow = P.out + (size_t)row * D + kh * 512;
        bf16_t* hbrow = hb + (size_t)row * D + kh * 512;
        if (tid < 32) lcnt[tid] = 0u;
        mf4 acc[3];
#pragma unroll
        for (int i = 0; i < 3; ++i) acc[i] = (mf4){0.f, 0.f, 0.f, 0.f};
        float ss = 0.f;
        f32x4 breg[3], areg[4];
#pragma unroll
        for (int j = 0; j < 3; ++j) { const int f = tid + 512 * j, hh = f / 768, rem = f % 768, n = rem >> 4, c4 = rem & 15; breg[j] = *(const f32x4*)(wrT + (size_t)n * D + hh * 512 + c4 * 4); }
#pragma unroll
        for (int kk = 0; kk < 4; ++kk) areg[kk] = *(const f32x4*)(hrow + kk * 16 + 4 * q);
#pragma unroll
        for (int j = 0; j < 3; ++j) { const int f = tid + 512 * j, hh = f / 768, rem = f % 768, n = rem >> 4, c4 = rem & 15; *(LAS f32x4*)(bbuf + ((hh * 48 + n) * 68 + c4 * 4)) = breg[j]; }
        __syncthreads();
        for (int ch = 0; ch < 8; ++ch) {
            f32x4 acur[4];
#pragma unroll
            for (int kk = 0; kk < 4; ++kk) acur[kk] = areg[kk];
            if (ch + 1 < 8) {
#pragma unroll
                for (int j = 0; j < 3; ++j) { const int f = tid + 512 * j, hh = f / 768, rem = f % 768, n = rem >> 4, c4 = rem & 15; breg[j] = *(const f32x4*)(wrT + (size_t)n * D + hh * 512 + (ch + 1) * 64 + c4 * 4); }
#pragma unroll
                for (int kk = 0; kk < 4; ++kk) areg[kk] = *(const f32x4*)(hrow + (ch + 1) * 64 + kk * 16 + 4 * q);
            }
            const LAS float* bb = bbuf + (ch & 1) * (2 * 48 * 68) + kh * 48 * 68;
#pragma unroll
            for (int kk = 0; kk < 4; ++kk) {
                const f32x4 a = acur[kk];
#pragma unroll
                for (int ntile = 0; ntile < 3; ++ntile) { const f32x4 b = *(const LAS f32x4*)(bb + (ntile * 16 + li) * 68 + kk * 16 + 4 * q);
#pragma unroll
                    for (int s = 0; s < 4; ++s) acc[ntile] = __builtin_amdgcn_mfma_f32_16x16x4f32(a[s], b[s], acc[ntile], 0, 0, 0); }
                ss += (a[0] * a[0] + a[1] * a[1]) + (a[2] * a[2] + a[3] * a[3]);
                u32x2 w; w.x = cvt_pk_bf16(a[0], a[1]); w.y = cvt_pk_bf16(a[2], a[3]); *(u32x2*)(hbrow + ch * 64 + kk * 16 + 4 * q) = w;
            }
            if (ch + 1 < 8) {
#pragma unroll
                for (int j = 0; j < 3; ++j) { const int f = tid + 512 * j, hh = f / 768, rem = f % 768, n = rem >> 4, c4 = rem & 15; *(LAS f32x4*)(bbuf + ((ch + 1) & 1) * (2 * 48 * 68) + ((hh * 48 + n) * 68 + c4 * 4)) = breg[j]; }
            }
            __syncthreads();
        }
        ss += __shfl_xor(ss, 16); ss += __shfl_xor(ss, 32);
        if (q == 0) ssp[kh * 64 + tg * 16 + li] = ss;
#pragma unroll
        for (int ntile = 0; ntile < 3; ++ntile)
#pragma unroll
            for (int rg = 0; rg < 4; ++rg) part[(kh * 64 + tg * 16 + 4 * q + rg) * 49 + ntile * 16 + li] = acc[ntile][rg];
        __syncthreads();
        int ea = 0, eb = 0; unsigned pa = 0, pb = 0; const int t = item * 64 + tid;
        if (tid < 64) {
            const float r = __builtin_amdgcn_rsqf((ssp[tid] + ssp[64 + tid]) * (1.f / D) + EPS);
            float lg[36];
#pragma unroll
            for (int j = 0; j < 36; ++j) lg[j] = (part[tid * 49 + j] + part[(64 + tid) * 49 + j]) * r;
            float gl[4]; int gs = 0; float gm = -1e30f;
#pragma unroll
            for (int j = 0; j < 4; ++j) { gl[j] = lg[32 + j] + P.b_gr[l * 4 + j]; if (gl[j] > gm) { gm = gl[j]; gs = j; } }
            float gsum = 0.f;
#pragma unroll
            for (int j = 0; j < 4; ++j) gsum += __expf(gl[j] - gm);
            const float pg = 1.f / gsum;
            float el[8];
#pragma unroll
            for (int j = 0; j < 8; ++j) { float v = 0.f;
#pragma unroll
                for (int g = 0; g < 4; ++g) v = (g == gs) ? lg[g * 8 + j] : v;
                el[j] = v + P.b_er[l * 32 + gs * 8 + j]; }
            int i0 = 0; float v0 = el[0];
#pragma unroll
            for (int j = 1; j < 8; ++j) if (el[j] > v0) { v0 = el[j]; i0 = j; }
            int i1 = -1; float v1 = -1e30f;
#pragma unroll
            for (int j = 0; j < 8; ++j) if (j != i0 && el[j] > v1) { v1 = el[j]; i1 = j; }
            const float e1 = __expf(v1 - v0); const float g0 = pg / (1.f + e1), g1 = pg * e1 / (1.f + e1);
            rout[t] = r; gwv[2 * t] = g0; gwv[2 * t + 1] = g1;
            ea = gs * 8 + i0; eb = gs * 8 + i1;
            pa = __hip_atomic_fetch_add(&lcnt[ea], 1u, __ATOMIC_RELAXED, __HIP_MEMORY_SCOPE_WORKGROUP); pb = __hip_atomic_fetch_add(&lcnt[eb], 1u, __ATOMIC_RELAXED, __HIP_MEMORY_SCOPE_WORKGROUP);
        }
        __syncthreads();
        if (tid < 32) { const unsigned n = lcnt[tid]; lbase[tid] = n ? atomicAdd(&gcnt[tid], n) : 0u; }
        __syncthreads();
        if (tid < 64) { list[(size_t)ea * T + lbase[ea] + pa] = 2u * t; list[(size_t)eb * T + lbase[eb] + pb] = 2u * t + 1u; }
        __syncthreads();
    }
}

__device__ __forceinline__ void phase_combine(const Ptrs& P, bf16_t* hbn, float* hdst, int vcu, int G) {
    const int lane = threadIdx.x & 63, gw = vcu * NWAVES + (threadIdx.x >> 6), NGW = G * NWAVES;
    for (int row = gw; row < T; row += NGW) {
        const f32x4* h = (const f32x4*)(P.out + (size_t)row * D) + lane; f32x4* hd = (f32x4*)(hdst + (size_t)row * D) + lane; const u32x2* y = (const u32x2*)((const bf16_t*)(P.ws + WS_Y) + (size_t)row * 2 * D) + lane;
        f32x4 v[4]; float s = 0.f;
#pragma unroll
        for (int j = 0; j < 4; ++j) { v[j] = h[64 * j]; const u32x2 a = y[64 * j], b = y[256 + 64 * j];
            v[j][0] += __uint_as_float(a.x << 16) + __uint_as_float(b.x << 16); v[j][1] += __uint_as_float(a.x & 0xffff0000u) + __uint_as_float(b.x & 0xffff0000u);
            v[j][2] += __uint_as_float(a.y << 16) + __uint_as_float(b.y << 16); v[j][3] += __uint_as_float(a.y & 0xffff0000u) + __uint_as_float(b.y & 0xffff0000u);
            s += (v[j][0] * v[j][0] + v[j][1] * v[j][1]) + (v[j][2] * v[j][2] + v[j][3] * v[j][3]); }
        const float r = __builtin_amdgcn_rsqf(wave_sum(s) * (1.f / D) + EPS);
        u32x2* o = (u32x2*)(hbn + (size_t)row * D) + lane;
#pragma unroll
        for (int j = 0; j < 4; ++j) { hd[64 * j] = v[j]; u32x2 w; w.x = cvt_pk_bf16(v[j][0] * r, v[j][1] * r); w.y = cvt_pk_bf16(v[j][2] * r, v[j][3] * r); o[64 * j] = w; }
    }
}
__device__ __forceinline__ void phase_final(const Ptrs& P, float* hdst, int vcu, int G) {
    const int lane = threadIdx.x & 63, gw = vcu * NWAVES + (threadIdx.x >> 6), NGW = G * NWAVES;
    f32x4 gf[4];
#pragma unroll
    for (int j = 0; j < 4; ++j) gf[j] = *((const f32x4*)P.g_final + lane + 64 * j);
    for (int row = gw; row < T; row += NGW) {
        const f32x4* h = (const f32x4*)(P.out + (size_t)row * D) + lane; f32x4* hd = (f32x4*)(hdst + (size_t)row * D) + lane; f32x4 v[4]; float s = 0.f;
#pragma unroll
        for (int j = 0; j < 4; ++j) { v[j] = h[64 * j]; s += (v[j][0] * v[j][0] + v[j][1] * v[j][1]) + (v[j][2] * v[j][2] + v[j][3] * v[j][3]); }
        const float r = __builtin_amdgcn_rsqf(wave_sum(s) * (1.f / D) + EPS);
#pragma unroll
        for (int j = 0; j < 4; ++j) hd[64 * j] = v[j] * r * gf[j];
    }
}
constexpr int AT_KSTR = 144, AT_VSTR = 520, AT_VOFF = 256 * AT_KSTR;
__device__ __forceinline__ int crow16(int reg, int h) { return (reg & 3) + 8 * (reg >> 2) + 4 * h; }
__device__ __forceinline__ void phase_attn(const Ptrs& P, LAS unsigned char* lds, int G) {
    const int tid = threadIdx.x, lane = tid & 63, wave = __builtin_amdgcn_readfirstlane(tid >> 6), r32 = lane & 31, hh = lane >> 5;
    const bf16_t* Qb = (const bf16_t*)(P.ws + WS_Q); const bf16_t* Kb = (const bf16_t*)(P.ws + WS_K); const bf16_t* Vb = (const bf16_t*)(P.ws + WS_V); bf16_t* Ob = (bf16_t*)(P.ws + WS_O);
    for (int unit = blockIdx.x; unit < 2 * 64 * 4; unit += G) {
        const int kh = unit & 3, nb = (unit >> 2) & 63, b = unit >> 8;
        const int tq0 = b * SEQ + nb * 128;
        __syncthreads();
        {
            const int key = tid >> 1, hf = tid & 1; const bool ok = (nb > 0) || (key >= 128);
            u32x4 kv[4], vv[4];
#pragma unroll
            for (int i = 0; i < 4; ++i) { kv[i] = (u32x4){0u, 0u, 0u, 0u}; vv[i] = (u32x4){0u, 0u, 0u, 0u}; }
            if (ok) { const size_t go = (size_t)(tq0 - 128 + key) * KD + kh * 64 + hf * 32;
#pragma unroll
                for (int i = 0; i < 4; ++i) { kv[i] = *(const u32x4*)(Kb + go + 8 * i); vv[i] = *(const u32x4*)(Vb + go + 8 * i); } }
#pragma unroll
            for (int i = 0; i < 4; ++i) *(LAS u32x4*)(lds + key * AT_KSTR + hf * 64 + 16 * i) = kv[i];
#pragma unroll
            for (int i = 0; i < 4; ++i)
#pragma unroll
                for (int e = 0; e < 4; ++e) { const unsigned w = vv[i][e]; const int d = hf * 32 + 8 * i + 2 * e;
                    *(LAS bf16_t*)(lds + AT_VOFF + d * AT_VSTR + key * 2) = (bf16_t)(w & 0xffffu); *(LAS bf16_t*)(lds + AT_VOFF + (d + 1) * AT_VSTR + key * 2) = (bf16_t)(w >> 16); }
        }
        __syncthreads();
        const int g = wave >> 1, head = kh * 4 + g; const float sink = P.sinks[head] * LOG2E;
        for (int qq = 0; qq < 2; ++qq) {
            const int qi = (wave & 1) * 2 + qq;
            const int tq = tq0 + qi * 32 + r32;
            bf16x8 qf[4];
#pragma unroll
            for (int s = 0; s < 4; ++s) qf[s] = *(const bf16x8*)(Qb + (size_t)tq * D + head * 64 + 16 * s + 8 * hh);
            f32x16 st[5];
#pragma unroll
            for (int kt = 0; kt < 5; ++kt) {
                f32x16 a;
#pragma unroll
                for (int i = 0; i < 16; ++i) a[i] = 0.f;
                const LAS unsigned char* kp = lds + (32 * (qi + kt) + r32) * AT_KSTR + 16 * hh;
#pragma unroll
                for (int s = 0; s < 4; ++s) { const bf16x8 kf = *(const LAS bf16x8*)(kp + 32 * s); a = __builtin_amdgcn_mfma_f32_32x32x16_bf16(kf, qf[s], a, 0, 0, 0); }
                st[kt] = a;
            }
            const int iq = qi * 32 + r32;
            float mx = sink;
#pragma unroll
            for (int kt = 0; kt < 5; ++kt)
#pragma unroll
                for (int i = 0; i < 16; ++i) { const int jb = 32 * (qi + kt) + crow16(i, hh); const bool valid = (jb > iq) && (jb <= iq + 128) && (nb > 0 || jb >= 128);
                    const float v = valid ? st[kt][i] : -1e30f; st[kt][i] = v; mx = fmaxf(mx, v); }
            mx = fmaxf(mx, __shfl_xor(mx, 32));
            float sum = 0.f;
#pragma unroll
            for (int kt = 0; kt < 5; ++kt)
#pragma unroll
                for (int i = 0; i < 16; ++i) { const float e = __builtin_amdgcn_exp2f(st[kt][i] - mx); st[kt][i] = e; sum += e; }
            sum += __shfl_xor(sum, 32);
            const float inv = 1.f / (sum + __builtin_amdgcn_exp2f(sink - mx));
            f32x16 o0, o1;
#pragma unroll
            for (int i = 0; i < 16; ++i) { o0[i] = 0.f; o1[i] = 0.f; }
#pragma unroll
            for (int kt = 0; kt < 5; ++kt)
#pragma unroll
                for (int s = 0; s < 2; ++s) {
                    u32x4 pw; pw.x = cvt_pk_bf16(st[kt][8 * s + 0], st[kt][8 * s + 1]); pw.y = cvt_pk_bf16(st[kt][8 * s + 2], st[kt][8 * s + 3]);
                    pw.z = cvt_pk_bf16(st[kt][8 * s + 4], st[kt][8 * s + 5]); pw.w = cvt_pk_bf16(st[kt][8 * s + 6], st[kt][8 * s + 7]);
                    const bf16x8 pf = __builtin_bit_cast(bf16x8, pw);
                    const int key0 = 32 * (qi + kt) + 16 * s + 4 * hh;
                    const LAS unsigned char* vp0 = lds + AT_VOFF + r32 * AT_VSTR + key0 * 2; const LAS unsigned char* vp1 = vp0 + 32 * AT_VSTR;
                    const s16x4 a00 = *(const LAS s16x4*)(vp0), a01 = *(const LAS s16x4*)(vp0 + 16), a10 = *(const LAS s16x4*)(vp1), a11 = *(const LAS s16x4*)(vp1 + 16);
                    const bf16x8 v0 = __builtin_shufflevector(a00, a01, 0, 1, 2, 3, 4, 5, 6, 7), v1 = __builtin_shufflevector(a10, a11, 0, 1, 2, 3, 4, 5, 6, 7);
                    o0 = __builtin_amdgcn_mfma_f32_32x32x16_bf16(v0, pf, o0, 0, 0, 0);
                    o1 = __builtin_amdgcn_mfma_f32_32x32x16_bf16(v1, pf, o1, 0, 0, 0);
                }
            bf16_t* op = Ob + (size_t)tq * D + head * 64 + 4 * hh;
#pragma unroll
            for (int gq = 0; gq < 4; ++gq) {
                u32x2 w0, w1; w0.x = cvt_pk_bf16(o0[4 * gq] * inv, o0[4 * gq + 1] * inv); w0.y = cvt_pk_bf16(o0[4 * gq + 2] * inv, o0[4 * gq + 3] * inv);
                w1.x = cvt_pk_bf16(o1[4 * gq] * inv, o1[4 * gq + 1] * inv); w1.y = cvt_pk_bf16(o1[4 * gq + 2] * inv, o1[4 * gq + 3] * inv);
                *(u32x2*)(op + 8 * gq) = w0; *(u32x2*)(op + 32 + 8 * gq) = w1;
            }
        }
    }
}

constexpr int NPHASE = 16;
struct Args { Ptrs P; int ph_lo, ph_hi; };
__global__ void __launch_bounds__(NTHREADS, 2) yoco_fwd(Args args) {
    extern __shared__ __attribute__((aligned(16))) unsigned char lds_raw[];
    LAS unsigned char* lds = (LAS unsigned char*)lds_raw;
    const Ptrs& P = args.P;
    const int tid = threadIdx.x, G = gridDim.x, bx = blockIdx.x;
    const int vcu = (G % 8 == 0) ? (bx % 8) * (G / 8) + bx / 8 : bx;
    volatile LAS unsigned* MISC = (volatile LAS unsigned*)(lds + MISC_OFF);
    if (tid < 4) MISC[tid] = 0u;
    __syncthreads();
    const int lo = args.ph_lo, hi = args.ph_hi;
    const bool multi = (hi - lo) > 1;
    XcdBarrier bar; bar.bar = (unsigned*)(P.ws + WS_CTL) + CW_BAR; bar.x = 0; bar.st = MISC;
    if (multi) bar = xcd_barrier_post((unsigned*)(P.ws + WS_CTL) + CW_BAR, MISC);
    bf16_t* HBA = (bf16_t*)(P.ws + WS_HBA); bf16_t* HBB = (bf16_t*)(P.ws + WS_HBB);
    LAS int* tt = (LAS int*)(lds + TT_OFF);
#ifdef ONLY_PH
#define IN(k) ((k) == ONLY_PH)
#else
#define IN(k) (lo <= (k) && (k) < hi)
#endif
#define SEAM(k) do { if (IN(k) && IN((k) + 1)) xcd_barrier(bar); } while (0)
#ifndef REPEAT_MASK
#define REPEAT_MASK 0u
#endif
#define REP(k) if ((REPEAT_MASK >> (k)) & 1u)
    float* const DRYH = (float*)(P.ws + 448 * MiB); bf16_t* const DRYB = (bf16_t*)(P.ws + WS_ACT);
    unsigned* const CNT0 = (unsigned*)(P.ws + WS_CTL) + CW_CNT; unsigned* const LIST = (unsigned*)(P.ws + WS_LIST); float* const ROUT = (float*)(P.ws + WS_RX) + T;
    float* const SS3 = (float*)(P.ws + WS_CTL) + CW_SS3;
    if (IN(0)) { phase_prologue(P, lds, vcu, G); REP(0) { xcd_barrier(bar); phase_prologue(P, lds, vcu, G); } } SEAM(0);
    if (IN(1)) {
        REP(1) { { JobPool J; J.P = P; J.G = G; J.c = bx; g8::gemm_phase(lds, J); } { JobUp J; J.P = P; J.G = G; J.c = bx; g8::gemm_phase(lds, J); } xcd_barrier(bar); }
        { JobPool J; J.P = P; J.G = G; J.c = bx; g8::gemm_phase(lds, J); }
        { JobUp J; J.P = P; J.G = G; J.c = bx; g8::gemm_phase(lds, J); }
    } SEAM(1);
    if (IN(2)) { phase_router(P, 0, HBA, CNT0, LIST, ROUT, lds, G); REP(2) { xcd_barrier(bar); phase_router(P, 0, HBB, CNT0 + 128, (unsigned*)DRYH, (float*)DRYH + 32 * T, lds, G); } } SEAM(2);
    if (IN(3)) { build_tile_table(P, 0, tt); for (int rep = 0; rep < 1 + ((REPEAT_MASK >> 3) & 1u); ++rep) { if (rep) xcd_barrier(bar); JobGateUp J; J.P = P; J.G = G; J.c = bx; J.l = 0; J.hb = HBA; J.tt = tt; g8::gemm_phase(lds, J); } } SEAM(3);
    if (IN(4)) { build_tile_table(P, 0, tt); for (int rep = 0; rep < 1 + ((REPEAT_MASK >> 4) & 1u); ++rep) { if (rep) xcd_barrier(bar); JobDown J; J.P = P; J.G = G; J.c = bx; J.l = 0; J.tt = tt; g8::gemm_phase(lds, J); } } SEAM(4);
    if (IN(5)) { REP(5) { phase_combine(P, HBA, DRYH, vcu, G); xcd_barrier(bar); } phase_combine(P, HBB, P.out, vcu, G); } SEAM(5);
    if (IN(6)) { REP(6) { JobPle J; J.P = P; J.G = G; J.c = bx; J.l = 0; J.hbn = HBB; J.hb3 = DRYB; J.hdst = DRYH; J.ss3 = SS3 + T; g8::gemm_phase(lds, J); xcd_barrier(bar); }
                 JobPle J; J.P = P; J.G = G; J.c = bx; J.l = 0; J.hbn = HBB; J.hb3 = HBA; J.hdst = P.out; J.ss3 = SS3; g8::gemm_phase(lds, J); } SEAM(6);
    if (IN(7)) { REP(7) { JobKvq J; J.P = P; J.G = G; J.c = bx; J.hb3 = HBA; g8::gemm_phase(lds, J); xcd_barrier(bar); }
                 JobKvq J; J.P = P; J.G = G; J.c = bx; J.hb3 = HBA; g8::gemm_phase(lds, J); } SEAM(7);
    if (IN(8)) { for (int rep = 0; rep < 1 + ((REPEAT_MASK >> 8) & 1u); ++rep) { if (rep) xcd_barrier(bar); phase_attn(P, lds, G); __syncthreads(); } } SEAM(8);
    if (IN(9)) { REP(9) { JobOproj J; J.P = P; J.G = G; J.c = bx; J.hdst = DRYH; g8::gemm_phase(lds, J); xcd_barrier(bar); }
                 JobOproj J; J.P = P; J.G = G; J.c = bx; J.hdst = P.out; g8::gemm_phase(lds, J); } SEAM(9);
    if (IN(10)) { phase_router(P, 1, HBA, CNT0 + 64, LIST, ROUT, lds, G); REP(10) { xcd_barrier(bar); phase_router(P, 1, HBB, CNT0 + 192, (unsigned*)DRYH, (float*)DRYH + 32 * T, lds, G); } } SEAM(10);
    if (IN(11)) { build_tile_table(P, 1, tt); for (int rep = 0; rep < 1 + ((REPEAT_MASK >> 11) & 1u); ++rep) { if (rep) xcd_barrier(bar); JobGateUp J; J.P = P; J.G = G; J.c = bx; J.l = 1; J.hb = HBA; J.tt = tt; g8::gemm_phase(lds, J); } } SEAM(11);
    if (IN(12)) { build_tile_table(P, 1, tt); for (int rep = 0; rep < 1 + ((REPEAT_MASK >> 12) & 1u); ++rep) { if (rep) xcd_barrier(bar); JobDown J; J.P = P; J.G = G; J.c = bx; J.l = 1; J.tt = tt; g8::gemm_phase(lds, J); } } SEAM(12);
    if (IN(13)) { REP(13) { phase_combine(P, HBA, DRYH, vcu, G); xcd_barrier(bar); } phase_combine(P, HBB, P.out, vcu, G); } SEAM(13);
    if (IN(14)) { REP(14) { JobPle J; J.P = P; J.G = G; J.c = bx; J.l = 1; J.hbn = HBB; J.hb3 = nullptr; J.hdst = DRYH; J.ss3 = SS3 + T; g8::gemm_phase(lds, J); xcd_barrier(bar); }
                  JobPle J; J.P = P; J.G = G; J.c = bx; J.l = 1; J.hbn = HBB; J.hb3 = nullptr; J.hdst = P.out; J.ss3 = SS3; g8::gemm_phase(lds, J); } SEAM(14);
    if (IN(15)) { REP(15) { phase_final(P, DRYH, vcu, G); xcd_barrier(bar); } phase_final(P, P.out, vcu, G); }
#undef IN
#undef SEAM
}
#if HYBRID
__global__ void k_rms_x(Ptrs P) {
    const int row = blockIdx.x * 4 + (threadIdx.x >> 6), lane = threadIdx.x & 63;
    const float* xr = P.x + (size_t)row * D; float s = 0.f;
    for (int i = lane; i < D; i += 64) s += xr[i] * xr[i];
    s = wave_sum(s);
    if (lane == 0) ((float*)(P.ws + WS_RX))[row] = rsqrtf(s * (1.f / D) + EPS);
}
__global__ void k_cs(Ptrs P) {
    const int i = blockIdx.x * blockDim.x + threadIdx.x; if (i >= T * 32) return;
    const int t = i >> 5, j = i & 31;
    const float inv = powf(10000.f, -(float)(2 * j) / 64.f);
    const float ang = (float)P.pos[t] * inv;
    const double a = (double)ang; const double rev = a * 0.15915494309189535; const double fr = rev - rint(rev);
    const float f = (float)fr * 6.283185307179586f;
    ((float2*)(P.ws + WS_CS))[i] = make_float2(cosf(f), sinf(f));
}
__global__ void k_pooldiff(Ptrs P) {
    const size_t i = (size_t)blockIdx.x * blockDim.x + threadIdx.x; const int t = (int)(i >> 10), c = (int)(i & 1023);
    const int gi = c >> 8, w = 2 << gi, s = t & (SEQ - 1); const int cnt = (s + 1 < w) ? s + 1 : w;
    const float* rx = (const float*)(P.ws + WS_RX); const float g = P.g_mix[c];
    float sum = 0.f;
    for (int j = 0; j < cnt; ++j) sum += P.x[(size_t)(t - j) * D + c] * rx[t - j] * g;
    const float hn = P.x[(size_t)t * D + c] * rx[t] * g;
    ((bf16_t*)(P.ws + WS_D16))[i] = f2bf(sum / (float)cnt - hn);
}
__global__ void k_p16(Ptrs P) {
    const size_t i = (size_t)blockIdx.x * blockDim.x + threadIdx.x; if (i >= (size_t)2 * T * PD) return;
    ((bf16_t*)(P.ws + WS_P16))[i] = f2bf(P.p[i]);
}
template <class F> __global__ void k_ngemm(F f) {
    const int n = blockIdx.x * 256 + threadIdx.x, m0 = blockIdx.y * 8;
    if (!f.begin(m0)) return;
    f.m0 = m0;
    float acc[8], acc2[8];
#pragma unroll
    for (int i = 0; i < 8; ++i) { acc[i] = 0.f; acc2[i] = 0.f; }
    const int K = f.K();
    for (int k = 0; k < K; ++k) {
        float w, w2; f.w(k, n, w, w2);
#pragma unroll
        for (int i = 0; i < 8; ++i) { const float a = f.a(i, k); acc[i] += a * w; acc2[i] += a * w2; }
    }
#pragma unroll
    for (int i = 0; i < 8; ++i) f.epi(i, n, acc[i], acc2[i]);
}
struct FPool {
    Ptrs P; int m0;
    __device__ bool begin(int) { return true; }
    __device__ int K() const { return 256; }
    __device__ void w(int k, int n, float& w, float& w2) const { w = P.pool_w[((size_t)(n >> 8) * 256 + k) * 256 + (n & 255)]; w2 = 0.f; }
    __device__ float a(int i, int k) const { return bf2f(((const bf16_t*)(P.ws + WS_D16))[(size_t)(m0 + i) * D + (blockIdx.x) * 256 + k]); }
    __device__ void epi(int i, int n, float acc, float) const { const int m = m0 + i; P.out[(size_t)m * D + n] = P.x[(size_t)m * D + n] + acc * P.pool_scale[n]; }
};
struct FUp {
    Ptrs P; int l; int m0;
    __device__ bool begin(int) { return true; }
    __device__ int K() const { return PD; }
    __device__ void w(int k, int n, float& w, float& w2) const { w = P.w_pu[((size_t)l * PD + k) * D + n]; w2 = 0.f; }
    __device__ float a(int i, int k) const { return bf2f(((const bf16_t*)(P.ws + WS_P16))[((size_t)l * T + m0 + i) * PD + k]); }
    __device__ void epi(int i, int n, float acc, float) const { ((bf16_t*)(P.ws + WS_U))[((size_t)l * T + m0 + i) * D + n] = f2bf(acc); }
};
__global__ void k_router(Ptrs P, int l, bf16_t* hb) {
    const int t = blockIdx.x * blockDim.x + threadIdx.x; if (t >= T) return;
    const float* h = P.out + (size_t)t * D;
    float lg[36];
#pragma unroll
    for (int j = 0; j < 36; ++j) lg[j] = 0.f;
    float ss = 0.f;
    for (int k = 0; k < D; ++k) {
        const float v = h[k]; ss += v * v; hb[(size_t)t * D + k] = f2bf(v);
        const float hv = v * P.g_ffn[l * D + k];
#pragma unroll
        for (int j = 0; j < 32; ++j) lg[j] += hv * P.w_er[((size_t)l * D + k) * 32 + j];
#pragma unroll
        for (int j = 0; j < 4; ++j) lg[32 + j] += hv * P.w_gr[((size_t)l * D + k) * 4 + j];
    }
    const float r = rsqrtf(ss * (1.f / D) + EPS);
    ((float*)(P.ws + WS_RX))[T + t] = r;
    float gl[4]; int gs = 0; float gm = -1e30f;
#pragma unroll
    for (int j = 0; j < 4; ++j) { gl[j] = lg[32 + j] * r + P.b_gr[l * 4 + j]; if (gl[j] > gm) { gm = gl[j]; gs = j; } }
    float gsum = 0.f;
#pragma unroll
    for (int j = 0; j < 4; ++j) gsum += expf(gl[j] - gm);
    const float pg = 1.f / gsum;
    float el[8];
#pragma unroll
    for (int j = 0; j < 8; ++j) {
        float v = 0.f;
#pragma unroll
        for (int g = 0; g < 4; ++g) v = (g == gs) ? lg[g * 8 + j] : v;
        el[j] = v * r + P.b_er[l * 32 + gs * 8 + j];
    }
    int i0 = 0; float v0 = el[0];
#pragma unroll
    for (int j = 1; j < 8; ++j) if (el[j] > v0) { v0 = el[j]; i0 = j; }
    int i1 = -1; float v1 = -1e30f;
#pragma unroll
    for (int j = 0; j < 8; ++j) if (j != i0 && el[j] > v1) { v1 = el[j]; i1 = j; }
    const float e1 = expf(v1 - v0); const float g0 = pg / (1.f + e1), g1 = pg * e1 / (1.f + e1);
    float* gw = (float*)(P.ws + WS_RX) + 2 * T;
    gw[2 * t] = g0; gw[2 * t + 1] = g1;
    unsigned* cnt = (unsigned*)(P.ws + WS_CTL) + CW_CNT + 64 * l; unsigned* list = (unsigned*)(P.ws + WS_LIST);
    const int ea = gs * 8 + i0, eb = gs * 8 + i1;
    const unsigned pa = atomicAdd(&cnt[ea], 1u); list[(size_t)ea * T + pa] = 2u * t;
    const unsigned pb = atomicAdd(&cnt[eb], 1u); list[(size_t)eb * T + pb] = 2u * t + 1u;
}
__device__ __forceinline__ bool tile_lookup(const unsigned* cnt, int tile, int& e, int& j, int& c) {
    int tb = 0;
    for (int i = 0; i < NE; ++i) { const int ci = (int)cnt[i], nt = (ci + 255) >> 8; if (tile < tb + nt) { e = i; j = tile - tb; c = ci; return true; } tb += nt; }
    return false;
}
struct FGateUp {
    Ptrs P; int l; const bf16_t* hb; int e, j, c; int m0; int en[8];
    __device__ bool begin(int mm) { if (!tile_lookup((const unsigned*)(P.ws + WS_CTL) + CW_CNT + 64 * l, mm >> 8, e, j, c)) return false;
#pragma unroll
        for (int i = 0; i < 8; ++i) en[i] = ent(mm + i);
        return true; }
    __device__ int K() const { return D; }
    __device__ void w(int k, int n, float& w, float& w2) const { const float g = P.g_ffn[l * D + k];
        w = g * P.w_eg[(((size_t)l * NE + e) * D + k) * DE + n]; w2 = g * P.w_eu[(((size_t)l * NE + e) * D + k) * DE + n]; }
    __device__ int ent(int m) const { int idx = j * 256 + (m & 255); if (idx >= c) idx = c - 1; return (int)((const unsigned*)(P.ws + WS_LIST))[(size_t)e * T + idx]; }
    __device__ float a(int i, int k) const { return bf2f(hb[(size_t)(en[i] >> 1) * D + k]); }
    __device__ void epi(int i, int n, float G, float U) const { const int m = m0 + i; const float r = ((const float*)(P.ws + WS_RX))[T + (en[i] >> 1)], gw = ((const float*)(P.ws + WS_RX))[2 * T + en[i]];
        G *= r; U *= r; const float a = gw * (G / (1.f + __expf(-G))) * U; ((bf16_t*)(P.ws + WS_ACT))[(size_t)m * DE + n] = f2bf(a); }
};
struct FDown {
    Ptrs P; int l; int e, j, c; int m0;
    __device__ bool begin(int mm) { return tile_lookup((const unsigned*)(P.ws + WS_CTL) + CW_CNT + 64 * l, mm >> 8, e, j, c); }
    __device__ int K() const { return DE; }
    __device__ void w(int k, int n, float& w, float& w2) const { w = P.w_ed[(((size_t)l * NE + e) * DE + k) * D + n]; w2 = 0.f; }
    __device__ float a(int i, int k) const { return bf2f(((const bf16_t*)(P.ws + WS_ACT))[(size_t)(m0 + i) * DE + k]); }
    __device__ void epi(int i, int n, float acc, float) const { const int m = m0 + i; const int idx = j * 256 + (m & 255); if (idx >= c) return;
        const unsigned en = ((const unsigned*)(P.ws + WS_LIST))[(size_t)e * T + idx]; ((bf16_t*)(P.ws + WS_Y))[(size_t)en * D + n] = f2bf(acc); }
};
__global__ void k_combine(Ptrs P, bf16_t* hbn) {
    const int row = blockIdx.x * 4 + (threadIdx.x >> 6), lane = threadIdx.x & 63;
    float* h = P.out + (size_t)row * D; const bf16_t* y = (const bf16_t*)(P.ws + WS_Y) + (size_t)row * 2 * D;
    float v[16]; float s = 0.f;
#pragma unroll
    for (int i = 0; i < 16; ++i) { const int c = lane + 64 * i; v[i] = h[c] + bf2f(y[c]) + bf2f(y[D + c]); s += v[i] * v[i]; }
    s = wave_sum(s); const float r = rsqrtf(s * (1.f / D) + EPS);
#pragma unroll
    for (int i = 0; i < 16; ++i) { const int c = lane + 64 * i; h[c] = v[i]; hbn[(size_t)row * D + c] = f2bf(v[i] * r); }
}
struct FPle {
    Ptrs P; int l; const bf16_t* hbn; bf16_t* hb3; int m0;
    __device__ bool begin(int) { return true; }
    __device__ int K() const { return D; }
    __device__ void w(int k, int n, float& w, float& w2) const { w = P.g_ple[l * D + k] * P.w_pg[((size_t)l * D + k) * D + n]; w2 = 0.f; }
    __device__ float a(int i, int k) const { return bf2f(hbn[(size_t)(m0 + i) * D + k]); }
    __device__ void epi(int i, int n, float G, float) const { const int m = m0 + i; const float u = bf2f(((const bf16_t*)(P.ws + WS_U))[((size_t)l * T + m) * D + n]);
        const float h = P.out[(size_t)m * D + n] + u / (1.f + __expf(-G)); P.out[(size_t)m * D + n] = h;
        if (hb3) { hb3[(size_t)m * D + n] = f2bf(h); atomicAdd((float*)(P.ws + WS_CTL) + CW_SS3 + m, h * h); } }
};
struct FKvq {
    Ptrs P; const bf16_t* hb3; int m0;
    __device__ bool begin(int) { return true; }
    __device__ int K() const { return D; }
    __device__ void w(int k, int n, float& w, float& w2) const {
        if (n < 256) { const int kh = n >> 6, c = n & 63, d = (c >> 1) + 32 * (c & 1), dp = d ^ 32; const float g = P.g_kv[k]; w = g * P.w_k[(size_t)k * KD + kh * 64 + d]; w2 = g * P.w_k[(size_t)k * KD + kh * 64 + dp]; }
        else if (n < 512) { w = P.g_kv[k] * P.w_v[(size_t)k * KD + (n - 256)]; w2 = 0.f; }
        else { const int q = n - 512, hh = q >> 6, c = q & 63, d = (c >> 1) + 32 * (c & 1), dp = d ^ 32; const float g = P.g_mix[D + k]; w = g * P.w_q[(size_t)k * D + hh * 64 + d]; w2 = g * P.w_q[(size_t)k * D + hh * 64 + dp]; }
    }
    __device__ float a(int i, int k) const { return bf2f(hb3[(size_t)(m0 + i) * D + k]); }
    __device__ void epi(int i, int n, float a1, float a2) const { const int m = m0 + i;
        const float r = rsqrtf(((const float*)(P.ws + WS_CTL))[CW_SS3 + m] * (1.f / D) + EPS); a1 *= r; a2 *= r;
        if (n >= 256 && n < 512) { ((bf16_t*)(P.ws + WS_V))[(size_t)m * KD + (n - 256)] = f2bf(a1); return; }
        const int c = n & 63, pi = c >> 1; const float2 cs = ((const float2*)(P.ws + WS_CS))[(size_t)m * 32 + pi];
        const float o = (c & 1) ? (a1 * cs.x + a2 * cs.y) : (a1 * cs.x - a2 * cs.y);
        if (n < 256) ((bf16_t*)(P.ws + WS_K))[(size_t)m * KD + n] = f2bf(o);
        else ((bf16_t*)(P.ws + WS_Q))[(size_t)m * D + (n - 512)] = f2bf(o * QSCALE);
    }
};
__global__ void __launch_bounds__(64) k_attn(Ptrs P) {
    const int i = blockIdx.x * blockDim.x + threadIdx.x; const int t = i >> 4, h = i & 15, kh = h >> 2, s = t & (SEQ - 1);
    const bf16_t* Q = (const bf16_t*)(P.ws + WS_Q) + (size_t)t * D + h * 64; const bf16_t* Kb = (const bf16_t*)(P.ws + WS_K); const bf16_t* Vb = (const bf16_t*)(P.ws + WS_V);
    float q[64];
#pragma unroll
    for (int d = 0; d < 64; ++d) q[d] = bf2f(Q[d]);
    const int nk = (s + 1 < 128) ? s + 1 : 128; const float sink = P.sinks[h] * LOG2E;
    float m = sink;
    for (int j = 0; j < nk; ++j) { const bf16_t* kr = Kb + (size_t)(t - j) * KD + kh * 64; float sc = 0.f;
#pragma unroll
        for (int d = 0; d < 64; ++d) sc += q[d] * bf2f(kr[d]);
        m = fmaxf(m, sc); }
    float o[64];
#pragma unroll
    for (int d = 0; d < 64; ++d) o[d] = 0.f;
    float den = exp2f(sink - m);
    for (int j = 0; j < nk; ++j) { const bf16_t* kr = Kb + (size_t)(t - j) * KD + kh * 64; const bf16_t* vr = Vb + (size_t)(t - j) * KD + kh * 64; float sc = 0.f;
#pragma unroll
        for (int d = 0; d < 64; ++d) sc += q[d] * bf2f(kr[d]);
        const float e = exp2f(sc - m); den += e;
#pragma unroll
        for (int d = 0; d < 64; ++d) o[d] += e * bf2f(vr[d]); }
    const float inv = 1.f / den; bf16_t* O = (bf16_t*)(P.ws + WS_O) + (size_t)t * D + h * 64;
#pragma unroll
    for (int d = 0; d < 64; ++d) O[d] = f2bf(o[d] * inv);
}
struct FOproj {
    Ptrs P; int m0;
    __device__ bool begin(int) { return true; }
    __device__ int K() const { return D; }
    __device__ void w(int k, int n, float& w, float& w2) const { w = P.w_o[(size_t)k * D + n]; w2 = 0.f; }
    __device__ float a(int i, int k) const { return bf2f(((const bf16_t*)(P.ws + WS_O))[(size_t)(m0 + i) * D + k]); }
    __device__ void epi(int i, int n, float acc, float) const { P.out[(size_t)(m0 + i) * D + n] += acc; }
};
__global__ void k_final(Ptrs P) {
    const int row = blockIdx.x * 4 + (threadIdx.x >> 6), lane = threadIdx.x & 63;
    float* h = P.out + (size_t)row * D; float v[16]; float s = 0.f;
#pragma unroll
    for (int i = 0; i < 16; ++i) { v[i] = h[lane + 64 * i]; s += v[i] * v[i]; }
    s = wave_sum(s); const float r = rsqrtf(s * (1.f / D) + EPS);
#pragma unroll
    for (int i = 0; i < 16; ++i) h[lane + 64 * i] = v[i] * r * P.g_final[lane + 64 * i];
}

#endif
#ifndef HYBRID
#define HYBRID 0
#endif
#ifndef NAIVE_MASK
#define NAIVE_MASK 0u
#endif
extern "C" void kernel_launch(void* const* d_in, const int* in_sizes, int n_in, void* d_out, int out_size, void* d_ws, size_t ws_size, hipStream_t stream) {
    static int grid = 0;
    if (grid == 0) {
        if (n_in != 24 || in_sizes[0] != T * D || out_size != T * D || ws_size < WS_END) { fprintf(stderr, "kernel_launch: unexpected problem (n_in %d, ws %zu)\n", n_in, ws_size); grid = -1; return; }
        int dev = 0, cus = 0, per_cu = 0;
        if (hipGetDevice(&dev) != hipSuccess || hipDeviceGetAttribute(&cus, hipDeviceAttributeMultiprocessorCount, dev) != hipSuccess) { grid = -1; return; }
        if (hipFuncSetAttribute((const void*)yoco_fwd, hipFuncAttributeMaxDynamicSharedMemorySize, LDS_BYTES) != hipSuccess) { fprintf(stderr, "kernel_launch: hipFuncSetAttribute failed\n"); grid = -1; return; }
        if (hipOccupancyMaxActiveBlocksPerMultiprocessor(&per_cu, (const void*)yoco_fwd, NTHREADS, LDS_BYTES) != hipSuccess || per_cu < 1) { fprintf(stderr, "kernel_launch: occupancy query says %d\n", per_cu); }
        (void)hipGetLastError();
        grid = cus;
    }
    if (grid < 0) return;
    Ptrs P; memset(&P, 0, sizeof P);
    P.x = (const float*)d_in[0]; P.p = (const float*)d_in[1]; P.pos = (const int*)d_in[2]; P.g_mix = (const float*)d_in[3]; P.g_ffn = (const float*)d_in[4];
    P.pool_w = (const float*)d_in[5]; P.pool_scale = (const float*)d_in[6]; P.g_kv = (const float*)d_in[7]; P.w_k = (const float*)d_in[8]; P.w_v = (const float*)d_in[9];
    P.w_q = (const float*)d_in[10]; P.w_o = (const float*)d_in[11]; P.sinks = (const float*)d_in[12]; P.w_gr = (const float*)d_in[13]; P.b_gr = (const float*)d_in[14];
    P.w_er = (const float*)d_in[15]; P.b_er = (const float*)d_in[16]; P.w_eg = (const float*)d_in[17]; P.w_eu = (const float*)d_in[18]; P.w_ed = (const float*)d_in[19];
    P.g_ple = (const float*)d_in[20]; P.w_pg = (const float*)d_in[21]; P.w_pu = (const float*)d_in[22]; P.g_final = (const float*)d_in[23];
    P.out = (float*)d_out; P.ws = (unsigned char*)d_ws;
    (void)hipMemsetAsync(P.ws + WS_CTL, 0, 1 * MiB, stream);
    Args a; memset(&a, 0, sizeof a); a.P = P;
#if !HYBRID
    a.ph_lo = 0; a.ph_hi = NPHASE;
    hipLaunchKernelGGL(yoco_fwd, dim3(grid), dim3(NTHREADS), LDS_BYTES, stream, a);
#else
    bf16_t* HBA = (bf16_t*)(P.ws + WS_HBA); bf16_t* HBB = (bf16_t*)(P.ws + WS_HBB);
    for (int ph = 0; ph < NPHASE; ++ph) {
        const bool naive = (NAIVE_MASK >> ph) & 1u;
        if (!naive || ph == 0) { a.ph_lo = ph; a.ph_hi = ph + 1; hipLaunchKernelGGL(yoco_fwd, dim3(grid), dim3(NTHREADS), LDS_BYTES, stream, a); }
        if (!naive) continue;
        const int l = ph >= 10 ? 1 : 0;
        switch (ph) {
        case 0: k_rms_x<<<T / 4, 256, 0, stream>>>(P); k_cs<<<T * 32 / 256, 256, 0, stream>>>(P); k_pooldiff<<<T * D / 256, 256, 0, stream>>>(P); k_p16<<<2 * T * PD / 256, 256, 0, stream>>>(P); break;
        case 1: { FPool f; memset(&f, 0, sizeof f); f.P = P; k_ngemm<FPool><<<dim3(4, T / 8), 256, 0, stream>>>(f); }
                for (int ll = 0; ll < 2; ++ll) { FUp f; memset(&f, 0, sizeof f); f.P = P; f.l = ll; k_ngemm<FUp><<<dim3(4, T / 8), 256, 0, stream>>>(f); } break;
        case 2: case 10: k_router<<<T / 64, 64, 0, stream>>>(P, l, HBA); break;
        case 3: case 11: { FGateUp f; memset(&f, 0, sizeof f); f.P = P; f.l = l; f.hb = HBA; k_ngemm<FGateUp><<<dim3(2, 160 * 256 / 8), 256, 0, stream>>>(f); } break;
        case 4: case 12: { FDown f; memset(&f, 0, sizeof f); f.P = P; f.l = l; k_ngemm<FDown><<<dim3(4, 160 * 256 / 8), 256, 0, stream>>>(f); } break;
        case 5: case 13: k_combine<<<T / 4, 256, 0, stream>>>(P, HBB); break;
        case 6: case 14: { FPle f; memset(&f, 0, sizeof f); f.P = P; f.l = l; f.hbn = HBB; f.hb3 = (l == 0) ? HBA : nullptr; k_ngemm<FPle><<<dim3(4, T / 8), 256, 0, stream>>>(f); } break;
        case 7: { FKvq f; memset(&f, 0, sizeof f); f.P = P; f.hb3 = HBA; k_ngemm<FKvq><<<dim3(6, T / 8), 256, 0, stream>>>(f); } break;
        case 8: k_attn<<<T * 16 / 64, 64, 0, stream>>>(P); break;
        case 9: { FOproj f; memset(&f, 0, sizeof f); f.P = P; k_ngemm<FOproj><<<dim3(4, T / 8), 256, 0, stream>>>(f); } break;
        case 15: k_final<<<T / 4, 256, 0, stream>>>(P); break;
        }
    }
#endif
}
```

```cpp
#define HYBRID 0
#define NAIVE_MASK 0u
#define REPEAT_MASK 0u
#include <hip/hip_runtime.h>
#include <cstdio>
#include <cstdint>
#include <cstring>

#define LAS __attribute__((address_space(3)))
typedef unsigned short bf16_t;
typedef short bf16x8 __attribute__((ext_vector_type(8)));
typedef short s16x4 __attribute__((ext_vector_type(4)));
typedef float f32x2 __attribute__((ext_vector_type(2)));
typedef float f32x4 __attribute__((ext_vector_type(4)));
typedef float f32x16 __attribute__((ext_vector_type(16)));
typedef unsigned u32x2 __attribute__((ext_vector_type(2)));
typedef unsigned u32x4 __attribute__((ext_vector_type(4)));

constexpr int T = 16384, D = 1024, SEQ = 8192, NE = 32, DE = 512, PD = 256, HD = 64, NQH = 16, NKVH = 4, KD = 256;
constexpr float EPS = 1e-6f;
constexpr float LOG2E = 1.4426950408889634f;
constexpr float QSCALE = 0.125f * LOG2E;
constexpr int NTHREADS = 512, NWAVES = 8;

__device__ __forceinline__ bf16_t f2bf(float f) { unsigned u = __float_as_uint(f); u += 0x7fffu + ((u >> 16) & 1u); return (bf16_t)(u >> 16); }
__device__ __forceinline__ float bf2f(bf16_t b) { return __uint_as_float(((unsigned)b) << 16); }
__device__ __forceinline__ unsigned cvt_pk_bf16(float lo, float hi) { unsigned r; asm volatile("v_cvt_pk_bf16_f32 %0, %1, %2" : "=v"(r) : "v"(lo), "v"(hi)); return r; }
__device__ __forceinline__ float wave_sum(float v) {
#pragma unroll
    for (int o = 1; o < 64; o <<= 1) v += __shfl_xor(v, o);
    return v;
}
__device__ __forceinline__ float fast_sigmoid(float x) { return __builtin_amdgcn_rcpf(1.f + __builtin_amdgcn_exp2f(-x * LOG2E)); }

constexpr size_t MiB = 1u << 20;
constexpr size_t WS_CTL = 0;
constexpr size_t WS_CS = 1 * MiB;
constexpr size_t WS_RX = 5 * MiB;
constexpr size_t WS_LIST = 6 * MiB;
constexpr size_t WS_U = 8 * MiB;
constexpr size_t WS_HBA = 72 * MiB;
constexpr size_t WS_HBB = 104 * MiB;
constexpr size_t WS_ACT = 136 * MiB;
constexpr size_t WS_Y = 176 * MiB;
constexpr size_t WS_W = 240 * MiB;
constexpr size_t WS_P16 = WS_ACT;
constexpr size_t WS_D16 = WS_Y;
constexpr size_t WS_Q = WS_Y;
constexpr size_t WS_O = WS_Y + 32 * MiB;
constexpr size_t WS_K = WS_ACT;
constexpr size_t WS_V = WS_ACT + 8 * MiB;
constexpr size_t WW_GU = 0;
constexpr size_t WW_DN = 128 * MiB;
constexpr size_t WW_PLEG = 192 * MiB;
constexpr size_t WW_PLEU = 196 * MiB;
constexpr size_t WW_KVQ = 197 * MiB;
constexpr size_t WW_WO = 200 * MiB;
constexpr size_t WW_POOL = 202 * MiB;
constexpr size_t WW_WR = 203 * MiB;
constexpr size_t WS_END = WS_W + 204 * MiB;
constexpr int CW_BAR = 4096;
constexpr int CW_CNT = 8192;
constexpr int CW_SS3 = 16384;

struct Ptrs {
    const float *x, *p; const int* pos; const float *g_mix, *g_ffn, *pool_w, *pool_scale, *g_kv, *w_k, *w_v, *w_q, *w_o, *sinks,
        *w_gr, *b_gr, *w_er, *b_er, *w_eg, *w_eu, *w_ed, *g_ple, *w_pg, *w_pu, *g_final;
    float* out; unsigned char* ws;
};

#define XB_TMO      128
#define XB_XCNT(j)  (256  + 64 * (j))
#define XB_XSUB(j)  (1280 + 64 * (j))
#define XB_XGEN(j)  (2304 + 64 * (j))
#define XB_TOP      3328
#define XB_TOPGEN   3392
#define XCD_BAR_WORDS 3456
#define XB_SPIN_CAP (1u << 18)
__device__ __forceinline__ unsigned xb_ld(unsigned* p)              { return __hip_atomic_load(p, __ATOMIC_RELAXED, __HIP_MEMORY_SCOPE_AGENT); }
__device__ __forceinline__ unsigned xb_add(unsigned* p, unsigned v) { return __hip_atomic_fetch_add(p, v, __ATOMIC_RELAXED, __HIP_MEMORY_SCOPE_AGENT); }
__device__ __forceinline__ unsigned xb_xcc_id() { return (unsigned)__builtin_amdgcn_s_getreg((3 << 11) | 20) & 0xFu; }
#define XB_SPIN(cond, bar) do { unsigned _sp = 0; while (cond) { __builtin_amdgcn_s_sleep(1); \
    if ((++_sp & 255u) == 0u) { if (xb_ld(&(bar)[XB_TMO])) break; if (_sp > XB_SPIN_CAP) { atomicAdd(&(bar)[XB_TMO], 1u); break; } } } } while (0)
struct XcdBarrier { unsigned* bar; unsigned x; volatile LAS unsigned* st; };
__device__ __forceinline__ XcdBarrier xcd_barrier_post(unsigned* bar, volatile LAS unsigned* st) {
    XcdBarrier b; b.bar = bar; b.x = xb_xcc_id(); b.st = st;
    if (threadIdx.x == 0) (void)xb_add(&bar[XB_XCNT(b.x)], 1u);
    return b;
}
__device__ __forceinline__ void xcd_barrier_complete(unsigned* bar, unsigned x, unsigned& nloc, unsigned& nx) {
    const unsigned G = gridDim.x * gridDim.y * gridDim.z;
    unsigned sum, cnt, mine, sp = 0u;
    for (;;) {
        sum = 0u; cnt = 0u; mine = 0u;
#pragma unroll
        for (unsigned j = 0; j < 16; ++j) { const unsigned c = xb_ld(&bar[XB_XCNT(j)]); sum += c; cnt += (c > 0u) ? 1u : 0u; mine = (j == x) ? c : mine; }
        if (sum == G) break;
        __builtin_amdgcn_s_sleep(1);
        if ((++sp & 255u) == 0u) { if (xb_ld(&bar[XB_TMO])) break; if (sp > XB_SPIN_CAP) { atomicAdd(&bar[XB_TMO], 1u); break; } }
    }
    nloc = mine > 0u ? mine : 1u; nx = cnt > 0u ? cnt : 1u;
}
__device__ __forceinline__ void xcd_barrier(const XcdBarrier& b) {
    asm volatile("s_waitcnt vmcnt(0)" ::: "memory");
    __syncthreads();
    if (threadIdx.x == 0) {
        unsigned* bar = b.bar;
        __builtin_amdgcn_s_waitcnt(0);
        unsigned nloc = b.st[0], nx = b.st[1];
        if (nloc == 0u) { xcd_barrier_complete(bar, b.x, nloc, nx); b.st[0] = nloc; b.st[1] = nx; }
        const unsigned old = xb_add(&bar[XB_XSUB(b.x)], 1u);
        const unsigned gen = old / nloc;
        if (old + 1u == (gen + 1u) * nloc) {
            __builtin_amdgcn_fence(__ATOMIC_RELEASE, "agent");
            asm volatile("s_waitcnt vmcnt(0)" ::: "memory");
            const unsigned og = xb_add(&bar[XB_TOP], 1u);
            const unsigned tg = og / nx;
            if (og + 1u == (tg + 1u) * nx) xb_add(&bar[XB_TOPGEN], 1u);
            else XB_SPIN(xb_ld(&bar[XB_TOPGEN]) == tg, bar);
            __builtin_amdgcn_fence(__ATOMIC_ACQUIRE, "agent");
            xb_add(&bar[XB_XGEN(b.x)], 1u);
            asm volatile("s_waitcnt vmcnt(0)" ::: "memory");
        } else {
            XB_SPIN(xb_ld(&bar[XB_XGEN(b.x)]) == gen, bar);
            __builtin_amdgcn_fence(__ATOMIC_ACQUIRE, "agent");
            asm volatile("s_waitcnt vmcnt(0)" ::: "memory");
        }
    }
    __syncthreads();
}

constexpr int RING_BYTES = 131072;
constexpr int MISC_OFF = RING_BYTES;
constexpr int TT_OFF = RING_BYTES + 256;
constexpr int LDS_BYTES = 147456;

namespace g8 {
constexpr int BM = 256, BK = 64, HALF = 128, HTB = HALF * BK * 2, NXCD = 8, WGM = 8;
__device__ __forceinline__ int lds_byte(int r, int c) { const int st = (r >> 4) * 2 + (c >> 5), rr = r & 15, cc = c & 31, ob = rr * 64 + cc * 2; return st * 1024 + (ob ^ (((ob >> 9) & 1) << 5)); }
__device__ __forceinline__ void stage_rc(int b, int& R, int& C) { const int st = b / 1024, sb = b % 1024, swz = sb ^ (((sb >> 9) & 1) << 5); R = (st >> 1) * 16 + swz / 64; C = (st & 1) * 32 + (swz % 64) / 2; }
__device__ __forceinline__ int perm32(int rho) { const int n = rho >> 4, i = rho & 15; return 8 * (i >> 2) + 4 * n + (i & 3); }
__device__ __forceinline__ int xcd_remap(int L, int nwg) { const int q = nwg / NXCD, r = nwg % NXCD, xcd = L % NXCD, off = L / NXCD; return (xcd < r ? xcd * (q + 1) : r * (q + 1) + (xcd - r) * q) + off; }
__device__ __forceinline__ bool dense_unit(int i, int G, int c, int nM, int nN, int& pm, int& pn) {
    const int nwg = nM * nN; const long L = (long)i * G + c; if (L >= nwg) return false;
    const int wgid = xcd_remap((int)L, nwg);
    const int nig = WGM * nN, gid = wgid / nig, fm = gid * WGM, gsz = (nM - fm) < WGM ? (nM - fm) : WGM;
    pm = fm + ((wgid % nig) % gsz); pn = (wgid % nig) / gsz; return true;
}

template <class Job>
__device__ __forceinline__ void gemm_phase(LAS unsigned char* lds, Job& J) {
    typedef typename Job::Unit Unit;
    constexpr int K = Job::K, nt = K / BK;
    static_assert(nt >= 4 && (nt % 2) == 0, "K must be a multiple of 128, >= 256");
    const int tid = threadIdx.x, wid = __builtin_amdgcn_readfirstlane(tid >> 6), lane = tid & 63, wr = wid >> 2, wc = wid & 3, fr = lane & 15, fq = lane >> 4;
    unsigned voffB[2];
#pragma unroll
    for (int i = 0; i < 2; ++i) { int R, C; stage_rc(tid * 16 + i * 8192, R, C); const int Rb = Job::PERM ? ((R & ~31) + perm32(R & 31)) : R; voffB[i] = (unsigned)(Rb * K + C) * 2u; }
    constexpr size_t kstep = (size_t)(BK * 2);
    constexpr size_t hstepB = (size_t)HALF * K * 2;
    const unsigned ldsw = (unsigned)wid * 1024u;
    const int aoff = lds_byte(wr * 64 + fr, fq * 8), boff = lds_byte(wc * 32 + fr, fq * 8);
#define G8_SA(b, h) (((b) * 2 + (h)) * HTB)
#define G8_SB(b, h) ((4 + (b) * 2 + (h)) * HTB)
#define G8_STAGE_B(bufoff, gbase) do { _Pragma("unroll") for (int _i = 0; _i < 2; ++_i) \
        __builtin_amdgcn_global_load_lds((const unsigned*)((const char*)(gbase) + voffB[_i]), (LAS unsigned*)(lds + (bufoff) + ldsw + _i * 8192), 16, 0, 0); } while (0)
#define G8_STAGE_A(bufoff, gbase, off2) do { _Pragma("unroll") for (int _i = 0; _i < 2; ++_i) \
        __builtin_amdgcn_global_load_lds((const unsigned*)((const char*)(gbase) + (off2)[_i]), (LAS unsigned*)(lds + (bufoff) + ldsw + _i * 8192), 16, 0, 0); } while (0)
#define G8_LDA(dst, b, h) do { _Pragma("unroll") for (int m = 0; m < 4; ++m) _Pragma("unroll") for (int k = 0; k < 2; ++k) dst[m][k] = *(const LAS bf16x8*)(lds + G8_SA(b, h) + aoff + m * 2048 + k * 1024); } while (0)
#define G8_LDB(dst, b, h) do { _Pragma("unroll") for (int n = 0; n < 2; ++n) _Pragma("unroll") for (int k = 0; k < 2; ++k) dst[n][k] = *(const LAS bf16x8*)(lds + G8_SB(b, h) + boff + n * 2048 + k * 1024); } while (0)
#define G8_MMA(ai, bj, At, Bt) do { __builtin_amdgcn_s_setprio(1); _Pragma("unroll") for (int m = 0; m < 4; ++m) _Pragma("unroll") for (int n = 0; n < 2; ++n) _Pragma("unroll") for (int k = 0; k < 2; ++k) \
        acc[ai][bj][m][n] = __builtin_amdgcn_mfma_f32_16x16x32_bf16(Bt[n][k], At[m][k], acc[ai][bj][m][n], 0, 0, 0); __builtin_amdgcn_s_setprio(0); } while (0)
#define G8_WAIT_V(n) asm volatile("s_waitcnt vmcnt(" #n ")" ::: "memory")
#define G8_WAIT_L(n) asm volatile("s_waitcnt lgkmcnt(" #n ")" ::: "memory")
#define G8_BAR __builtin_amdgcn_s_barrier()
#define G8_SCHED __builtin_amdgcn_sched_barrier(0)
    Unit cur, nxt; int ui = 0;
    if (!J.next(0, cur)) return;
    unsigned ao[2][2], no[2][2];
    { int tid_ = tid; asm volatile("" : "+v"(tid_)); J.a_offs(cur, tid_, ao); }
    f32x4 acc[2][2][4][2];
#pragma unroll
    for (int a = 0; a < 2; ++a)
#pragma unroll
        for (int b = 0; b < 2; ++b)
#pragma unroll
            for (int m = 0; m < 4; ++m)
#pragma unroll
                for (int n = 0; n < 2; ++n) acc[a][b][m][n] = (f32x4){0.f, 0.f, 0.f, 0.f};
    bf16x8 At[4][2], B0[2][2], B1[2][2];
    const char* cA = J.a_base(cur); const char* cB = J.b_base(cur);
    G8_STAGE_B(G8_SB(0, 0), cB); G8_STAGE_B(G8_SB(0, 1), cB + hstepB); G8_STAGE_A(G8_SA(0, 0), cA, ao[0]); G8_STAGE_A(G8_SA(0, 1), cA, ao[1]);
    if (wr == 1) G8_BAR;
    G8_WAIT_V(2); G8_BAR;
    G8_STAGE_B(G8_SB(1, 0), cB + kstep); G8_STAGE_A(G8_SA(1, 0), cA + kstep, ao[0]); G8_STAGE_B(G8_SB(1, 1), cB + hstepB + kstep);
    G8_WAIT_V(6); G8_BAR;
    for (;;) {
        const bool has_next = J.next(ui + 1, nxt);
        const char* nA = cA; const char* nB = cB;
#pragma unroll
        for (int h = 0; h < 2; ++h)
#pragma unroll
            for (int i = 0; i < 2; ++i) no[h][i] = ao[h][i];
        if (has_next) { nA = J.a_base(nxt); nB = J.b_base(nxt); int tid_ = tid; asm volatile("" : "+v"(tid_)); J.a_offs(nxt, tid_, no); }
#pragma unroll 1
        for (int t = 0; t < nt; t += 2) {
            const bool last = (t == nt - 2);
            const char* a1 = cA + (size_t)(t + 1) * kstep;
            const char* a2 = last ? nA : cA + (size_t)(t + 2) * kstep; const char* b2 = last ? nB : cB + (size_t)(t + 2) * kstep;
            const char* a3 = a2 + kstep; const char* b3 = b2 + kstep;
            unsigned o2[2][2];
#pragma unroll
            for (int h = 0; h < 2; ++h)
#pragma unroll
                for (int i = 0; i < 2; ++i) o2[h][i] = last ? no[h][i] : ao[h][i];
            G8_LDB(B0, 0, 0); G8_LDB(B1, 0, 1); G8_SCHED; G8_LDA(At, 0, 0); G8_STAGE_A(G8_SA(1, 1), a1, ao[1]);
            G8_WAIT_V(8); G8_WAIT_L(0); G8_BAR; G8_MMA(0, 0, At, B0); G8_MMA(0, 1, At, B1); G8_BAR; G8_SCHED;
            G8_LDA(At, 0, 1); G8_STAGE_B(G8_SB(0, 0), b2); G8_STAGE_B(G8_SB(0, 1), b2 + hstepB); G8_STAGE_A(G8_SA(0, 0), a2, o2[0]);
            G8_WAIT_V(8); G8_WAIT_L(0); G8_BAR; G8_MMA(1, 0, At, B0); G8_MMA(1, 1, At, B1); G8_BAR; G8_SCHED;
            G8_LDB(B0, 1, 0); G8_LDB(B1, 1, 1); G8_SCHED; G8_LDA(At, 1, 0); G8_STAGE_A(G8_SA(0, 1), a2, o2[1]);
            G8_WAIT_V(8); G8_WAIT_L(0); G8_BAR; G8_MMA(0, 0, At, B0); G8_MMA(0, 1, At, B1); G8_BAR; G8_SCHED;
            G8_LDA(At, 1, 1); G8_STAGE_B(G8_SB(1, 0), b3); G8_STAGE_B(G8_SB(1, 1), b3 + hstepB); G8_STAGE_A(G8_SA(1, 0), a3, o2[0]);
            G8_WAIT_V(8); G8_WAIT_L(0); G8_BAR; G8_MMA(1, 0, At, B0); G8_MMA(1, 1, At, B1); G8_BAR; G8_SCHED;
        }
        if (wr == 0) G8_BAR;
        { int fr_ = fr, fq_ = fq; asm volatile("" : "+v"(fr_), "+v"(fq_)); J.epi(acc, cur, wr, wc, fr_, fq_); }
        if (!has_next) break;
#pragma unroll
        for (int a = 0; a < 2; ++a)
#pragma unroll
            for (int b = 0; b < 2; ++b)
#pragma unroll
                for (int m = 0; m < 4; ++m)
#pragma unroll
                    for (int n = 0; n < 2; ++n) acc[a][b][m][n] = (f32x4){0.f, 0.f, 0.f, 0.f};
        cur = nxt; cA = nA; cB = nB; ++ui;
#pragma unroll
        for (int h = 0; h < 2; ++h)
#pragma unroll
            for (int i = 0; i < 2; ++i) ao[h][i] = no[h][i];
        if (wr == 1) G8_BAR;
    }
    G8_WAIT_V(0);
    G8_BAR;
#undef G8_SA
#undef G8_SB
#undef G8_STAGE_A
#undef G8_STAGE_B
#undef G8_LDA
#undef G8_LDB
#undef G8_MMA
#undef G8_WAIT_V
#undef G8_WAIT_L
#undef G8_BAR
#undef G8_SCHED
}
}
struct JobBase { Ptrs P; int G, c; };

__device__ __forceinline__ void dense_offs(int lda, int tid, unsigned (&o)[2][2]) {
#pragma unroll
    for (int i = 0; i < 2; ++i) { int R, C; g8::stage_rc(tid * 16 + i * 8192, R, C);
#pragma unroll
        for (int h = 0; h < 2; ++h) o[h][i] = (unsigned)((h * 128 + R) * lda + C) * 2u; }
}

struct JobPool : JobBase {
    static constexpr int K = 256; static constexpr bool PERM = true;
    struct Unit { int pm, pn; };
    bf16_t* hs;
    __device__ __forceinline__ bool next(int i, Unit& u) const { return g8::dense_unit(i, G, c, T / 256, 4, u.pm, u.pn); }
    __device__ __forceinline__ const char* a_base(const Unit& u) const { return (const char*)(P.ws + WS_D16) + ((size_t)u.pm * 256 * D + u.pn * 256) * 2; }
    __device__ __forceinline__ const char* b_base(const Unit& u) const { return (const char*)(P.ws + WS_W + WW_POOL) + (size_t)u.pn * 256 * 256 * 2; }
    __device__ __forceinline__ void a_offs(const Unit&, int tid, unsigned (&o)[2][2]) const { dense_offs(D, tid, o); }
    __device__ __forceinline__ void epi(const f32x4 (&acc)[2][2][4][2], const Unit& u, int wr, int wc, int fr, int fq) const {
        const int row0 = u.pm * 256 + wr * 64 + fr, col0 = u.pn * 256 + wc * 32 + 8 * fq;
#pragma unroll
        for (int ai = 0; ai < 2; ++ai) {
            f32x4 xv[4][2][2];
#pragma unroll
            for (int m = 0; m < 4; ++m) { const size_t ro = (size_t)(row0 + ai * 128 + m * 16) * D + col0;
#pragma unroll
                for (int bj = 0; bj < 2; ++bj)
#pragma unroll
                    for (int n = 0; n < 2; ++n) xv[m][bj][n] = __builtin_nontemporal_load((const f32x4*)(P.x + ro + bj * 128 + n * 4)); }
#pragma unroll
            for (int m = 0; m < 4; ++m) { const size_t ro = (size_t)(row0 + ai * 128 + m * 16) * D + col0;
#pragma unroll
                for (int bj = 0; bj < 2; ++bj) { const f32x4 v0 = xv[m][bj][0] + acc[ai][bj][m][0], v1 = xv[m][bj][1] + acc[ai][bj][m][1];
                    u32x4 w; w.x = cvt_pk_bf16(v0[0], v0[1]); w.y = cvt_pk_bf16(v0[2], v0[3]); w.z = cvt_pk_bf16(v1[0], v1[1]); w.w = cvt_pk_bf16(v1[2], v1[3]);
                    *(u32x4*)(hs + ro + bj * 128) = w; } }
        }
    }
};
struct JobUp : JobBase {
    static constexpr int K = 256; static constexpr bool PERM = true;
    struct Unit { int l, pm, pn; };
    __device__ __forceinline__ bool next(int i, Unit& u) const { int pm2; if (!g8::dense_unit(i, G, c, 2 * T / 256, 4, pm2, u.pn)) return false; u.l = pm2 >> 6; u.pm = pm2 & 63; return true; }
    __device__ __forceinline__ const char* a_base(const Unit& u) const { return (const char*)(P.ws + WS_P16) + ((size_t)u.l * T + (size_t)u.pm * 256) * PD * 2; }
    __device__ __forceinline__ const char* b_base(const Unit& u) const { return (const char*)(P.ws + WS_W + WW_PLEU) + ((size_t)u.l * D + (size_t)u.pn * 256) * PD * 2; }
    __device__ __forceinline__ void a_offs(const Unit&, int tid, unsigned (&o)[2][2]) const { dense_offs(PD, tid, o); }
    __device__ __forceinline__ void epi(const f32x4 (&acc)[2][2][4][2], const Unit& u, int wr, int wc, int fr, int fq) const {
        bf16_t* Ub = (bf16_t*)(P.ws + WS_U) + (size_t)u.l * T * D;
        const int row0 = u.pm * 256 + wr * 64 + fr, col0 = u.pn * 256 + wc * 32 + 8 * fq;
#pragma unroll
        for (int ai = 0; ai < 2; ++ai)
#pragma unroll
            for (int m = 0; m < 4; ++m) { bf16_t* rowp = Ub + (size_t)(row0 + ai * 128 + m * 16) * D + col0;
#pragma unroll
                for (int bj = 0; bj < 2; ++bj) { const f32x4 v0 = acc[ai][bj][m][0], v1 = acc[ai][bj][m][1];
                    u32x4 w; w.x = cvt_pk_bf16(v0[0], v0[1]); w.y = cvt_pk_bf16(v0[2], v0[3]); w.z = cvt_pk_bf16(v1[0], v1[1]); w.w = cvt_pk_bf16(v1[2], v1[3]);
                    *(u32x4*)(rowp + bj * 128) = w; } }
    }
};
__device__ __forceinline__ void build_tile_table(const Ptrs& P, int l, LAS int* tt) {
    const unsigned* cnt = (const unsigned*)(P.ws + WS_CTL) + CW_CNT + 64 * l;
    const int t = threadIdx.x;
    if (t < 161) {
        int tb = 0, lb = -1, nv = 0;
        for (int e = 0; e < NE; ++e) { const int ce = (int)cnt[e], ntl = (ce + 255) >> 8;
            if (t < 160 && t >= tb && t < tb + ntl) { const int j = t - tb; lb = e * T + 256 * j; nv = ce - 256 * j; if (nv > 256) nv = 256; }
            tb += ntl; }
        if (t == 160) tt[0] = tb; else { tt[1 + 2 * t] = lb; tt[2 + 2 * t] = nv; }
    }
    __syncthreads();
}
struct MoeUnit { int tile, pn, lb, nv; };
__device__ __forceinline__ bool moe_unit(int i, int G, int c, const LAS int* tt, MoeUnit& u) {
    const int ntiles = __builtin_amdgcn_readfirstlane(tt[0]); const int nwg = ntiles * 4;
    const long L = (long)i * G + c; if (L >= nwg) return false;
    const int v = g8::xcd_remap((int)L, nwg);
    u.tile = v >> 2; u.pn = v & 3; u.lb = __builtin_amdgcn_readfirstlane(tt[1 + 2 * u.tile]); u.nv = __builtin_amdgcn_readfirstlane(tt[2 + 2 * u.tile]); return true;
}
struct JobGateUp : JobBase {
    static constexpr int K = 1024; static constexpr bool PERM = true;
    typedef MoeUnit Unit;
    int l; const bf16_t* hb; const LAS int* tt; const float* rr;
    __device__ __forceinline__ bool next(int i, Unit& u) const { return moe_unit(i, G, c, tt, u); }
    __device__ __forceinline__ const char* a_base(const Unit&) const { return (const char*)hb; }
    __device__ __forceinline__ const char* b_base(const Unit& u) const { const int e = u.lb >> 14; return (const char*)(P.ws + WS_W + WW_GU) + (((size_t)l * NE + e) * 1024 + (size_t)u.pn * 256) * 1024 * 2; }
    __device__ __forceinline__ void a_offs(const Unit& u, int tid, unsigned (&o)[2][2]) const {
        const unsigned* list = (const unsigned*)(P.ws + WS_LIST) + u.lb;
#pragma unroll
        for (int i = 0; i < 2; ++i) { int R, C; g8::stage_rc(tid * 16 + i * 8192, R, C);
#pragma unroll
            for (int h = 0; h < 2; ++h) { int rt = h * 128 + R; rt = rt < u.nv ? rt : u.nv - 1; const unsigned en = list[rt]; o[h][i] = (en >> 1) * (unsigned)(D * 2) + (unsigned)C * 2u; } }
    }
    __device__ __forceinline__ void epi(const f32x4 (&acc)[2][2][4][2], const Unit& u, int wr, int wc, int fr, int fq) const {
        const unsigned* list = (const unsigned*)(P.ws + WS_LIST) + u.lb; const float* gwv = rr + T;
        bf16_t* act = (bf16_t*)(P.ws + WS_ACT) + (size_t)u.tile * 256 * DE + u.pn * 128 + wc * 32 + 8 * fq;
        unsigned en[2][4]; float rv[2][4], gv[2][4];
#pragma unroll
        for (int ai = 0; ai < 2; ++ai)
#pragma unroll
            for (int m = 0; m < 4; ++m) { const int rt = ai * 128 + wr * 64 + m * 16 + fr; const int rc = rt < u.nv ? rt : u.nv - 1; en[ai][m] = list[rc]; }
#pragma unroll
        for (int ai = 0; ai < 2; ++ai)
#pragma unroll
            for (int m = 0; m < 4; ++m) { rv[ai][m] = rr[en[ai][m] >> 1]; gv[ai][m] = gwv[en[ai][m]]; }
#pragma unroll
        for (int ai = 0; ai < 2; ++ai)
#pragma unroll
            for (int m = 0; m < 4; ++m) { const int rt = ai * 128 + wr * 64 + m * 16 + fr; const float r = rv[ai][m], gw = gv[ai][m];
                float o[8];
#pragma unroll
                for (int n = 0; n < 2; ++n)
#pragma unroll
                    for (int j = 0; j < 4; ++j) { const float g = acc[ai][0][m][n][j] * r, up = acc[ai][1][m][n][j] * r; o[n * 4 + j] = gw * g * fast_sigmoid(g) * up; }
                u32x4 w; w.x = cvt_pk_bf16(o[0], o[1]); w.y = cvt_pk_bf16(o[2], o[3]); w.z = cvt_pk_bf16(o[4], o[5]); w.w = cvt_pk_bf16(o[6], o[7]);
                *(u32x4*)(act + (size_t)rt * DE) = w; }
    }
};
struct JobDown : JobBase {
    static constexpr int K = 512; static constexpr bool PERM = true;
    typedef MoeUnit Unit;
    int l; const LAS int* tt;
    __device__ __forceinline__ bool next(int i, Unit& u) const { return moe_unit(i, G, c, tt, u); }
    __device__ __forceinline__ const char* a_base(const Unit& u) const { return (const char*)(P.ws + WS_ACT) + (size_t)u.tile * 256 * DE * 2; }
    __device__ __forceinline__ const char* b_base(const Unit& u) const { const int e = u.lb >> 14; return (const char*)(P.ws + WS_W + WW_DN) + (((size_t)l * NE + e) * 1024 + (size_t)u.pn * 256) * DE * 2; }
    __device__ __forceinline__ void a_offs(const Unit&, int tid, unsigned (&o)[2][2]) const { dense_offs(DE, tid, o); }
    __device__ __forceinline__ void epi(const f32x4 (&acc)[2][2][4][2], const Unit& u, int wr, int wc, int fr, int fq) const {
        const unsigned* list = (const unsigned*)(P.ws + WS_LIST) + u.lb;
        bf16_t* Y = (bf16_t*)(P.ws + WS_Y) + u.pn * 256 + wc * 32 + 8 * fq;
        unsigned en[2][4];
#pragma unroll
        for (int ai = 0; ai < 2; ++ai)
#pragma unroll
            for (int m = 0; m < 4; ++m) { const int rt = ai * 128 + wr * 64 + m * 16 + fr; en[ai][m] = list[rt < u.nv ? rt : u.nv - 1]; }
#pragma unroll
        for (int ai = 0; ai < 2; ++ai)
#pragma unroll
            for (int m = 0; m < 4; ++m) { const int rt = ai * 128 + wr * 64 + m * 16 + fr;
                if (rt < u.nv) { bf16_t* rowp = Y + (size_t)en[ai][m] * D;
#pragma unroll
                    for (int bj = 0; bj < 2; ++bj) { const f32x4 v0 = acc[ai][bj][m][0], v1 = acc[ai][bj][m][1];
                        u32x4 w; w.x = cvt_pk_bf16(v0[0], v0[1]); w.y = cvt_pk_bf16(v0[2], v0[3]); w.z = cvt_pk_bf16(v1[0], v1[1]); w.w = cvt_pk_bf16(v1[2], v1[3]);
                        *(u32x4*)(rowp + bj * 128) = w; } } }
    }
};
__device__ __forceinline__ float bflo(unsigned w) { return __uint_as_float(w << 16); }
__device__ __forceinline__ float bfhi(unsigned w) { return __uint_as_float(w & 0xffff0000u); }
struct JobPle : JobBase {
    static constexpr int K = 1024; static constexpr bool PERM = true;
    struct Unit { int pm, pn; };
    int l; const bf16_t* hs; bf16_t* hd; const float* rr; float* ss;
    __device__ __forceinline__ bool next(int i, Unit& u) const { return g8::dense_unit(i, G, c, T / 256, 4, u.pm, u.pn); }
    __device__ __forceinline__ const char* a_base(const Unit& u) const { return (const char*)hs + (size_t)u.pm * 256 * D * 2; }
    __device__ __forceinline__ const char* b_base(const Unit& u) const { return (const char*)(P.ws + WS_W + WW_PLEG) + ((size_t)l * D + (size_t)u.pn * 256) * D * 2; }
    __device__ __forceinline__ void a_offs(const Unit&, int tid, unsigned (&o)[2][2]) const { dense_offs(D, tid, o); }
    __device__ __forceinline__ void epi(const f32x4 (&acc)[2][2][4][2], const Unit& u, int wr, int wc, int fr, int fq) const {
        const bf16_t* Ub = (const bf16_t*)(P.ws + WS_U) + (size_t)l * T * D;
        const int row0 = u.pm * 256 + wr * 64 + fr, col0 = u.pn * 256 + wc * 32 + 8 * fq;
#pragma unroll
        for (int ai = 0; ai < 2; ++ai) {
            u32x4 hv[4][2], uv[4][2]; float rv[4];
#pragma unroll
            for (int m = 0; m < 4; ++m) { const int row = row0 + ai * 128 + m * 16; const size_t ro = (size_t)row * D + col0; rv[m] = rr[row];
#pragma unroll
                for (int bj = 0; bj < 2; ++bj) { hv[m][bj] = *(const u32x4*)(hs + ro + bj * 128); uv[m][bj] = *(const u32x4*)(Ub + ro + bj * 128); } }
#pragma unroll
            for (int m = 0; m < 4; ++m) { const int row = row0 + ai * 128 + m * 16; const size_t ro = (size_t)row * D + col0; const float r = rv[m]; float s2 = 0.f;
#pragma unroll
                for (int bj = 0; bj < 2; ++bj) { const u32x4 h = hv[m][bj], uu = uv[m][bj]; const f32x4 g0 = acc[ai][bj][m][0] * r, g1 = acc[ai][bj][m][1] * r; float o[8];
                    o[0] = bflo(h.x) + fast_sigmoid(g0[0]) * bflo(uu.x); o[1] = bfhi(h.x) + fast_sigmoid(g0[1]) * bfhi(uu.x);
                    o[2] = bflo(h.y) + fast_sigmoid(g0[2]) * bflo(uu.y); o[3] = bfhi(h.y) + fast_sigmoid(g0[3]) * bfhi(uu.y);
                    o[4] = bflo(h.z) + fast_sigmoid(g1[0]) * bflo(uu.z); o[5] = bfhi(h.z) + fast_sigmoid(g1[1]) * bfhi(uu.z);
                    o[6] = bflo(h.w) + fast_sigmoid(g1[2]) * bflo(uu.w); o[7] = bfhi(h.w) + fast_sigmoid(g1[3]) * bfhi(uu.w);
                    u32x4 w; w.x = cvt_pk_bf16(o[0], o[1]); w.y = cvt_pk_bf16(o[2], o[3]); w.z = cvt_pk_bf16(o[4], o[5]); w.w = cvt_pk_bf16(o[6], o[7]);
                    *(u32x4*)(hd + ro + bj * 128) = w;
                    const float q0 = bflo(w.x), q1 = bfhi(w.x), q2 = bflo(w.y), q3 = bfhi(w.y), q4 = bflo(w.z), q5 = bfhi(w.z), q6 = bflo(w.w), q7 = bfhi(w.w);
                    s2 += ((q0 * q0 + q1 * q1) + (q2 * q2 + q3 * q3)) + ((q4 * q4 + q5 * q5) + (q6 * q6 + q7 * q7)); }
                s2 += __shfl_xor(s2, 16); s2 += __shfl_xor(s2, 32); if (fq == 0) atomicAdd(ss + row, s2); }
        }
    }
};
struct JobKvq : JobBase {
    static constexpr int K = 1024; static constexpr bool PERM = true;
    struct Unit { int pm, pn; };
    const bf16_t* hb3; const float* ss3;
    __device__ __forceinline__ bool next(int i, Unit& u) const { return g8::dense_unit(i, G, c, T / 256, 6, u.pm, u.pn); }
    __device__ __forceinline__ const char* a_base(const Unit& u) const { return (const char*)hb3 + (size_t)u.pm * 256 * D * 2; }
    __device__ __forceinline__ const char* b_base(const Unit& u) const { return (const char*)(P.ws + WS_W + WW_KVQ) + (size_t)u.pn * 256 * D * 2; }
    __device__ __forceinline__ void a_offs(const Unit&, int tid, unsigned (&o)[2][2]) const { dense_offs(D, tid, o); }
    __device__ __forceinline__ void epi(const f32x4 (&acc)[2][2][4][2], const Unit& u, int wr, int wc, int fr, int fq) const {
        const float* cs = (const float*)(P.ws + WS_CS);
        const int row0 = u.pm * 256 + wr * 64 + fr, cw = wc * 32 + 8 * fq;
        bf16_t* dst; int ldd; float sc = 1.f;
        if (u.pn == 0) { dst = (bf16_t*)(P.ws + WS_K); ldd = KD; } else if (u.pn == 1) { dst = (bf16_t*)(P.ws + WS_V); ldd = KD; } else { dst = (bf16_t*)(P.ws + WS_Q) + (u.pn - 2) * 256; ldd = D; sc = QSCALE; }
        const bool rope = (u.pn != 1);
        float rv[2][4];
#pragma unroll
        for (int ai = 0; ai < 2; ++ai)
#pragma unroll
            for (int m = 0; m < 4; ++m) rv[ai][m] = ss3[row0 + ai * 128 + m * 16];
#pragma unroll
        for (int ai = 0; ai < 2; ++ai)
#pragma unroll
            for (int mp = 0; mp < 2; ++mp) {
                f32x4 cv[2][2][2];
                if (rope) {
#pragma unroll
                    for (int mm = 0; mm < 2; ++mm) { const int row = row0 + ai * 128 + (2 * mp + mm) * 16;
#pragma unroll
                        for (int bj = 0; bj < 2; ++bj) { const int pi = ((bj * 128 + cw) & 63) >> 1; cv[mm][bj][0] = *(const f32x4*)(cs + (size_t)row * 64 + pi * 2); cv[mm][bj][1] = *(const f32x4*)(cs + (size_t)row * 64 + pi * 2 + 4); } }
                }
#pragma unroll
                for (int mm = 0; mm < 2; ++mm) { const int m = 2 * mp + mm; const int row = row0 + ai * 128 + m * 16; const float r = __builtin_amdgcn_rsqf(rv[ai][m] * (1.f / D) + EPS) * sc;
#pragma unroll
                    for (int bj = 0; bj < 2; ++bj) { f32x4 v0 = acc[ai][bj][m][0] * r, v1 = acc[ai][bj][m][1] * r; const int cc = bj * 128 + cw;
                        if (rope) { const f32x4 c0 = cv[mm][bj][0], c1 = cv[mm][bj][1];
                            f32x4 w0, w1;
                            w0[0] = v0[0] * c0[0] - v0[1] * c0[1]; w0[1] = v0[1] * c0[0] + v0[0] * c0[1]; w0[2] = v0[2] * c0[2] - v0[3] * c0[3]; w0[3] = v0[3] * c0[2] + v0[2] * c0[3];
                            w1[0] = v1[0] * c1[0] - v1[1] * c1[1]; w1[1] = v1[1] * c1[0] + v1[0] * c1[1]; w1[2] = v1[2] * c1[2] - v1[3] * c1[3]; w1[3] = v1[3] * c1[2] + v1[2] * c1[3];
                            v0 = w0; v1 = w1; }
                        u32x4 w; w.x = cvt_pk_bf16(v0[0], v0[1]); w.y = cvt_pk_bf16(v0[2], v0[3]); w.z = cvt_pk_bf16(v1[0], v1[1]); w.w = cvt_pk_bf16(v1[2], v1[3]);
                        *(u32x4*)(dst + (size_t)row * ldd + cc) = w; } }
            }
    }
};
struct JobOproj : JobBase {
    static constexpr int K = 1024; static constexpr bool PERM = true;
    struct Unit { int pm, pn; };
    const bf16_t* hs; bf16_t* hd;
    __device__ __forceinline__ bool next(int i, Unit& u) const { return g8::dense_unit(i, G, c, T / 256, 4, u.pm, u.pn); }
    __device__ __forceinline__ const char* a_base(const Unit& u) const { return (const char*)(P.ws + WS_O) + (size_t)u.pm * 256 * D * 2; }
    __device__ __forceinline__ const char* b_base(const Unit& u) const { return (const char*)(P.ws + WS_W + WW_WO) + (size_t)u.pn * 256 * D * 2; }
    __device__ __forceinline__ void a_offs(const Unit&, int tid, unsigned (&o)[2][2]) const { dense_offs(D, tid, o); }
    __device__ __forceinline__ void epi(const f32x4 (&acc)[2][2][4][2], const Unit& u, int wr, int wc, int fr, int fq) const {
        const int row0 = u.pm * 256 + wr * 64 + fr, col0 = u.pn * 256 + wc * 32 + 8 * fq;
        u32x4 hv[2][4][2];
#pragma unroll
        for (int ai = 0; ai < 2; ++ai)
#pragma unroll
            for (int m = 0; m < 4; ++m) { const size_t ro = (size_t)(row0 + ai * 128 + m * 16) * D + col0;
#pragma unroll
                for (int bj = 0; bj < 2; ++bj) hv[ai][m][bj] = *(const u32x4*)(hs + ro + bj * 128); }
#pragma unroll
        for (int ai = 0; ai < 2; ++ai)
#pragma unroll
            for (int m = 0; m < 4; ++m) { const size_t ro = (size_t)(row0 + ai * 128 + m * 16) * D + col0;
#pragma unroll
                for (int bj = 0; bj < 2; ++bj) { const u32x4 h = hv[ai][m][bj]; const f32x4 a0 = acc[ai][bj][m][0], a1 = acc[ai][bj][m][1];
                    u32x4 w; w.x = cvt_pk_bf16(bflo(h.x) + a0[0], bfhi(h.x) + a0[1]); w.y = cvt_pk_bf16(bflo(h.y) + a0[2], bfhi(h.y) + a0[3]);
                    w.z = cvt_pk_bf16(bflo(h.z) + a1[0], bfhi(h.z) + a1[1]); w.w = cvt_pk_bf16(bflo(h.w) + a1[2], bfhi(h.w) + a1[3]);
                    *(u32x4*)(hd + ro + bj * 128) = w; } }
    }
};
__device__ __forceinline__ int tr_row(int mode, int roff, int n) {
    if (mode == 1) return roff + (n & ~63) + 2 * (n & 31) + ((n >> 5) & 1);
    if (mode == 2) return roff + (n >> 7) * 256 + (n & 127);
    return roff + n;
}
struct TrDesc { const float* W; int N; const float* ksc; const float* nsc; bf16_t* WT; int ldk, mode, roff, k0, n0; };
__device__ __forceinline__ void tr_load(const TrDesc& d, int lane, f32x4 (&v)[8]) {
    const int o = lane >> 3, q = lane & 7; const float* src = d.W + (size_t)(d.k0 + 8 * o) * d.N + d.n0 + 4 * q;
#pragma unroll
    for (int i = 0; i < 8; ++i) v[i] = __builtin_nontemporal_load((const f32x4*)(src + (size_t)i * d.N));
}
__device__ __forceinline__ void tr_store(const TrDesc& d, int lane, const f32x4 (&v)[8]) {
    const int o = lane >> 3, q = lane & 7;
    f32x4 k0v = (f32x4){1.f, 1.f, 1.f, 1.f}, k1v = k0v, nsv = k0v;
    if (d.ksc) { k0v = *(const f32x4*)(d.ksc + d.k0 + 8 * o); k1v = *(const f32x4*)(d.ksc + d.k0 + 8 * o + 4); }
    if (d.nsc) nsv = *(const f32x4*)(d.nsc + d.n0 + 4 * q);
#pragma unroll
    for (int j = 0; j < 4; ++j) { const float ns = nsv[j];
        u32x4 w; w.x = cvt_pk_bf16(v[0][j] * k0v[0] * ns, v[1][j] * k0v[1] * ns); w.y = cvt_pk_bf16(v[2][j] * k0v[2] * ns, v[3][j] * k0v[3] * ns);
        w.z = cvt_pk_bf16(v[4][j] * k1v[0] * ns, v[5][j] * k1v[1] * ns); w.w = cvt_pk_bf16(v[6][j] * k1v[2] * ns, v[7][j] * k1v[3] * ns);
        *(u32x4*)(d.WT + (size_t)tr_row(d.mode, d.roff, d.n0 + 4 * q + j) * d.ldk + d.k0 + 8 * o) = w; }
}
constexpr int N_TR_EXP = 64 * 768, N_TR_SMALL = 2688, N_TR_ITEMS = N_TR_EXP + N_TR_SMALL;
__device__ __forceinline__ TrDesc tr_desc(const Ptrs& P, int it) {
    bf16_t* Wb = (bf16_t*)(P.ws + WS_W); TrDesc d;
    if (it < N_TR_EXP) {
        const int le = it / 768, r = it % 768, which = r >> 8, r2 = r & 255, l = le >> 5;
        if (which < 2) d = TrDesc{(which ? P.w_eu : P.w_eg) + (size_t)le * D * DE, DE, P.g_ffn + l * D, nullptr, Wb + WW_GU / 2 + (size_t)le * 1024 * 1024, 1024, 2, which * 128, (r2 >> 4) * 64, (r2 & 15) * 32};
        else d = TrDesc{P.w_ed + (size_t)le * DE * D, D, nullptr, nullptr, Wb + WW_DN / 2 + (size_t)le * 1024 * DE, DE, 0, 0, (r2 >> 5) * 64, (r2 & 31) * 32};
        return d;
    }
    int s = it - N_TR_EXP;
    if (s < 1024) { const int l = s >> 9, r = s & 511; return TrDesc{P.w_pg + (size_t)l * D * D, D, P.g_ple + l * D, nullptr, Wb + WW_PLEG / 2 + (size_t)l * D * D, D, 0, 0, (r >> 5) * 64, (r & 31) * 32}; }
    s -= 1024;
    if (s < 256) { const int l = s >> 7, r = s & 127; return TrDesc{P.w_pu + (size_t)l * PD * D, D, nullptr, nullptr, Wb + WW_PLEU / 2 + (size_t)l * D * PD, PD, 0, 0, (r >> 5) * 64, (r & 31) * 32}; }
    s -= 256;
    if (s < 128) return TrDesc{P.w_k, KD, P.g_kv, nullptr, Wb + WW_KVQ / 2, D, 1, 0, (s >> 3) * 64, (s & 7) * 32};
    s -= 128;
    if (s < 128) return TrDesc{P.w_v, KD, P.g_kv, nullptr, Wb + WW_KVQ / 2, D, 0, 256, (s >> 3) * 64, (s & 7) * 32};
    s -= 128;
    if (s < 512) return TrDesc{P.w_q, D, P.g_mix + D, nullptr, Wb + WW_KVQ / 2, D, 1, 512, (s >> 5) * 64, (s & 31) * 32};
    s -= 512;
    if (s < 512) return TrDesc{P.w_o, D, nullptr, nullptr, Wb + WW_WO / 2, D, 0, 0, (s >> 5) * 64, (s & 31) * 32};
    s -= 512;
    { const int g = s >> 5, r = s & 31; return TrDesc{P.pool_w + (size_t)g * 65536, 256, nullptr, P.pool_scale + g * 256, Wb + WW_POOL / 2 + (size_t)g * 65536, 256, 0, 0, (r >> 3) * 64, (r & 7) * 32}; }
}
template <int W> __device__ __forceinline__ void pooldiff_cols(const Ptrs& P, int t0, int s0, const LAS float* rr, int c) {
    const float2 g = *(const float2*)(P.g_mix + c);
    float2 ring[16];
#pragma unroll
    for (int i = 0; i < 16; ++i) ring[i] = make_float2(0.f, 0.f);
    bf16_t* dout = (bf16_t*)(P.ws + WS_D16);
    for (int blk = 0; blk < 5; ++blk) {
#pragma unroll
        for (int jj = 0; jj < 16; ++jj) {
            const int j = blk * 16 + jj - 16;
            const int s = s0 + j;
            float2 v = make_float2(0.f, 0.f);
            if (s >= 0) { const float2 xv = *(const float2*)(P.x + (size_t)(t0 + j) * D + c); const float r = rr[j + 16]; v.x = xv.x * r * g.x; v.y = xv.y * r * g.y; }
            ring[jj] = v;
            if (j >= 0) {
                float2 sum = make_float2(0.f, 0.f);
#pragma unroll
                for (int q = 0; q < W; ++q) { const float2 e = ring[(jj - q) & 15]; sum.x += e.x; sum.y += e.y; }
                const int cnt = (s + 1 < W) ? s + 1 : W; const float ic = 1.f / (float)cnt;
                *(unsigned*)(dout + (size_t)(t0 + j) * D + c) = cvt_pk_bf16(sum.x * ic - v.x, sum.y * ic - v.y);
            }
        }
    }
}
__device__ __forceinline__ void phase_prologue(const Ptrs& P, LAS unsigned char* lds, int vcu, int G) {
    const int tid = threadIdx.x, lane = tid & 63, wave = tid >> 6;
    const int gw = vcu * NWAVES + wave, NGW = G * NWAVES;
    for (int it = gw; it < N_TR_ITEMS; it += 2 * NGW) {
        const int it2 = it + NGW; const bool has2 = it2 < N_TR_ITEMS;
        const TrDesc d0 = tr_desc(P, it), d1 = tr_desc(P, has2 ? it2 : it);
        f32x4 v0[8], v1[8];
        tr_load(d0, lane, v0); tr_load(d1, lane, v1);
        tr_store(d0, lane, v0); if (has2) tr_store(d1, lane, v1);
    }
    const size_t gt = (size_t)blockIdx.x * NTHREADS + tid, GT = (size_t)G * NTHREADS;
    { float* wr = (float*)(P.ws + WS_W + WW_WR);
      for (size_t i = gt; i < (size_t)2 * 48 * D; i += GT) { const int k = (int)(i & 1023), n = (int)((i >> 10) % 48), l = (int)(i / (48 * 1024));
          float v = 0.f; if (n < 32) v = P.w_er[((size_t)l * D + k) * 32 + n]; else if (n < 36) v = P.w_gr[((size_t)l * D + k) * 4 + (n - 32)];
          wr[i] = v * P.g_ffn[l * D + k]; } }
    { float2* cs = (float2*)(P.ws + WS_CS);
      for (size_t i = gt; i < (size_t)T * 32; i += GT) { const int t = (int)(i >> 5), j = (int)(i & 31);
          const float inv = exp2f(-(float)j * (13.287712379549449f / 32.f));
          const float ang = (float)P.pos[t] * inv; const double rev = (double)ang * 0.15915494309189535; const float fr = (float)(rev - rint(rev));
          cs[i] = make_float2(__builtin_amdgcn_cosf(fr), __builtin_amdgcn_sinf(fr)); } }
    { bf16_t* p16 = (bf16_t*)(P.ws + WS_P16);
      for (size_t i = gt; i < (size_t)2 * T * PD / 4; i += GT) { const f32x4 v = *(const f32x4*)(P.p + 4 * i); u32x2 w; w.x = cvt_pk_bf16(v[0], v[1]); w.y = cvt_pk_bf16(v[2], v[3]); *(u32x2*)(p16 + 4 * i) = w; } }
    __syncthreads();
    LAS float* rr = (LAS float*)lds;
    for (int ch = blockIdx.x; ch < T / 64; ch += G) {
        const int t0 = ch * 64, s0 = t0 & (SEQ - 1);
        for (int j = wave; j < 80; j += NWAVES) { const int s = s0 + j - 16; float r = 0.f;
            if (s >= 0) { const f32x4* xr = (const f32x4*)(P.x + (size_t)(t0 + j - 16) * D) + lane; float a = 0.f;
#pragma unroll
                for (int q = 0; q < 4; ++q) { const f32x4 v = xr[64 * q]; a += (v[0] * v[0] + v[1] * v[1]) + (v[2] * v[2] + v[3] * v[3]); }
                r = __builtin_amdgcn_rsqf(wave_sum(a) * (1.f / D) + EPS); }
            if (lane == 0) rr[j] = r; }
        __syncthreads();
        const int c = 2 * tid;
        switch (wave >> 1) { case 0: pooldiff_cols<2>(P, t0, s0, rr, c); break; case 1: pooldiff_cols<4>(P, t0, s0, rr, c); break; case 2: pooldiff_cols<8>(P, t0, s0, rr, c); break; default: pooldiff_cols<16>(P, t0, s0, rr, c); break; }
        __syncthreads();
    }
}

typedef float mf4 __attribute__((ext_vector_type(4)));
__device__ __forceinline__ void phase_router(const Ptrs& P, int l, const bf16_t* hs, unsigned* gcnt, unsigned* list, float* rout, LAS unsigned char* lds, int G) {
    const int tid = threadIdx.x, lane = tid & 63, wave = __builtin_amdgcn_readfirstlane(tid >> 6), tg = wave & 3, kh = wave >> 2, li = lane & 15, q = lane >> 4;
    LAS float* bbuf = (LAS float*)lds; LAS float* part = (LAS float*)(lds + 53248); LAS float* ssp = (LAS float*)(lds + 79872);
    LAS unsigned* lcnt = (LAS unsigned*)(lds + 80384); LAS unsigned* lbase = (LAS unsigned*)(lds + 80512);
    const float* wrT = (const float*)(P.ws + WS_W + WW_WR) + (size_t)l * 48 * D;
    float* gwv = rout + T;
    for (int item = blockIdx.x; item < T / 64; item += G) {
        const int row = item * 64 + tg * 16 + li;
        const bf16_t* hrow = hs + (size_t)row * D + kh * 512;
        if (tid < 32) lcnt[tid] = 0u;
        mf4 acc[3];
#pragma unroll
        for (int i = 0; i < 3; ++i) acc[i] = (mf4){0.f, 0.f, 0.f, 0.f};
        float ss = 0.f;
        f32x4 breg[3]; u32x4 areg[2];
#pragma unroll
        for (int j = 0; j < 3; ++j) { const int f = tid + 512 * j, hh = f / 768, rem = f % 768, n = rem >> 4, c4 = rem & 15; breg[j] = *(const f32x4*)(wrT + (size_t)n * D + hh * 512 + c4 * 4); }
#pragma unroll
        for (int c = 0; c < 2; ++c) areg[c] = *(const u32x4*)(hrow + c * 32 + 8 * q);
#pragma unroll
        for (int j = 0; j < 3; ++j) { const int f = tid + 512 * j, hh = f / 768, rem = f % 768, n = rem >> 4, c4 = rem & 15; *(LAS f32x4*)(bbuf + ((hh * 48 + n) * 68 + c4 * 4)) = breg[j]; }
        __syncthreads();
        for (int ch = 0; ch < 8; ++ch) {
            u32x4 acur[2];
#pragma unroll
            for (int c = 0; c < 2; ++c) acur[c] = areg[c];
            if (ch + 1 < 8) {
#pragma unroll
                for (int j = 0; j < 3; ++j) { const int f = tid + 512 * j, hh = f / 768, rem = f % 768, n = rem >> 4, c4 = rem & 15; breg[j] = *(const f32x4*)(wrT + (size_t)n * D + hh * 512 + (ch + 1) * 64 + c4 * 4); }
#pragma unroll
                for (int c = 0; c < 2; ++c) areg[c] = *(const u32x4*)(hrow + (ch + 1) * 64 + c * 32 + 8 * q);
            }
            const LAS float* bb = bbuf + (ch & 1) * (2 * 48 * 68) + kh * 48 * 68;
#pragma unroll
            for (int c = 0; c < 2; ++c) {
                const u32x4 aw = acur[c];
                float a[8]; a[0] = bflo(aw.x); a[1] = bfhi(aw.x); a[2] = bflo(aw.y); a[3] = bfhi(aw.y); a[4] = bflo(aw.z); a[5] = bfhi(aw.z); a[6] = bflo(aw.w); a[7] = bfhi(aw.w);
#pragma unroll
                for (int hf = 0; hf < 2; ++hf)
#pragma unroll
                    for (int ntile = 0; ntile < 3; ++ntile) { const f32x4 b = *(const LAS f32x4*)(bb + (ntile * 16 + li) * 68 + c * 32 + 8 * q + 4 * hf);
#pragma unroll
                        for (int s = 0; s < 4; ++s) acc[ntile] = __builtin_amdgcn_mfma_f32_16x16x4f32(a[4 * hf + s], b[s], acc[ntile], 0, 0, 0); }
#pragma unroll
                for (int j = 0; j < 8; ++j) ss += a[j] * a[j];
            }
            if (ch + 1 < 8) {
#pragma unroll
                for (int j = 0; j < 3; ++j) { const int f = tid + 512 * j, hh = f / 768, rem = f % 768, n = rem >> 4, c4 = rem & 15; *(LAS f32x4*)(bbuf + ((ch + 1) & 1) * (2 * 48 * 68) + ((hh * 48 + n) * 68 + c4 * 4)) = breg[j]; }
            }
            __syncthreads();
        }
        ss += __shfl_xor(ss, 16); ss += __shfl_xor(ss, 32);
        if (q == 0) ssp[kh * 64 + tg * 16 + li] = ss;
#pragma unroll
        for (int ntile = 0; ntile < 3; ++ntile)
#pragma unroll
            for (int rg = 0; rg < 4; ++rg) part[(kh * 64 + tg * 16 + 4 * q + rg) * 49 + ntile * 16 + li] = acc[ntile][rg];
        __syncthreads();
        int ea = 0, eb = 0; unsigned pa = 0, pb = 0; const int t = item * 64 + tid;
        if (tid < 64) {
            const float r = __builtin_amdgcn_rsqf((ssp[tid] + ssp[64 + tid]) * (1.f / D) + EPS);
            float lg[36];
#pragma unroll
            for (int j = 0; j < 36; ++j) lg[j] = (part[tid * 49 + j] + part[(64 + tid) * 49 + j]) * r;
            float gl[4]; int gs = 0; float gm = -1e30f;
#pragma unroll
            for (int j = 0; j < 4; ++j) { gl[j] = lg[32 + j] + P.b_gr[l * 4 + j]; if (gl[j] > gm) { gm = gl[j]; gs = j; } }
            float gsum = 0.f;
#pragma unroll
            for (int j = 0; j < 4; ++j) gsum += __expf(gl[j] - gm);
            const float pg = 1.f / gsum;
            float el[8];
#pragma unroll
            for (int j = 0; j < 8; ++j) { float v = 0.f;
#pragma unroll
                for (int g = 0; g < 4; ++g) v = (g == gs) ? lg[g * 8 + j] : v;
                el[j] = v + P.b_er[l * 32 + gs * 8 + j]; }
            int i0 = 0; float v0 = el[0];
#pragma unroll
            for (int j = 1; j < 8; ++j) if (el[j] > v0) { v0 = el[j]; i0 = j; }
            int i1 = -1; float v1 = -1e30f;
#pragma unroll
            for (int j = 0; j < 8; ++j) if (j != i0 && el[j] > v1) { v1 = el[j]; i1 = j; }
            const float e1 = __expf(v1 - v0); const float g0 = pg / (1.f + e1), g1 = pg * e1 / (1.f + e1);
            rout[t] = r; gwv[2 * t] = g0; gwv[2 * t + 1] = g1;
            ea = gs * 8 + i0; eb = gs * 8 + i1;
            pa = __hip_atomic_fetch_add(&lcnt[ea], 1u, __ATOMIC_RELAXED, __HIP_MEMORY_SCOPE_WORKGROUP); pb = __hip_atomic_fetch_add(&lcnt[eb], 1u, __ATOMIC_RELAXED, __HIP_MEMORY_SCOPE_WORKGROUP);
        }
        __syncthreads();
        if (tid < 32) { const unsigned n = lcnt[tid]; lbase[tid] = n ? atomicAdd(&gcnt[tid], n) : 0u; }
        __syncthreads();
        if (tid < 64) { list[(size_t)ea * T + lbase[ea] + pa] = 2u * t; list[(size_t)eb * T + lbase[eb] + pb] = 2u * t + 1u; }
        __syncthreads();
    }
}

__device__ __forceinline__ void unpack8(const u32x4 w, float (&o)[8]) { o[0] = bflo(w.x); o[1] = bfhi(w.x); o[2] = bflo(w.y); o[3] = bfhi(w.y); o[4] = bflo(w.z); o[5] = bfhi(w.z); o[6] = bflo(w.w); o[7] = bfhi(w.w); }
__device__ __forceinline__ void phase_combine(const Ptrs& P, const bf16_t* hs, bf16_t* hd, float* rr, int vcu, int G) {
    const int lane = threadIdx.x & 63, gw = vcu * NWAVES + (threadIdx.x >> 6), NGW = G * NWAVES;
    for (int row = gw; row < T; row += NGW) {
        const u32x4* h = (const u32x4*)(hs + (size_t)row * D) + lane; const u32x4* y = (const u32x4*)((const bf16_t*)(P.ws + WS_Y) + (size_t)row * 2 * D) + lane;
        u32x4 hw[2], y0[2], y1[2];
#pragma unroll
        for (int j = 0; j < 2; ++j) { hw[j] = h[64 * j]; y0[j] = y[64 * j]; y1[j] = y[128 + 64 * j]; }
        u32x4 ow[2]; float s = 0.f;
#pragma unroll
        for (int j = 0; j < 2; ++j) { float a[8], b[8], c[8]; unpack8(hw[j], a); unpack8(y0[j], b); unpack8(y1[j], c);
#pragma unroll
            for (int e = 0; e < 8; ++e) a[e] += b[e] + c[e];
            ow[j].x = cvt_pk_bf16(a[0], a[1]); ow[j].y = cvt_pk_bf16(a[2], a[3]); ow[j].z = cvt_pk_bf16(a[4], a[5]); ow[j].w = cvt_pk_bf16(a[6], a[7]);
            float qv[8]; unpack8(ow[j], qv);
#pragma unroll
            for (int e = 0; e < 8; ++e) s += qv[e] * qv[e]; }
        const float r = __builtin_amdgcn_rsqf(wave_sum(s) * (1.f / D) + EPS);
        u32x4* o = (u32x4*)(hd + (size_t)row * D) + lane;
#pragma unroll
        for (int j = 0; j < 2; ++j) o[64 * j] = ow[j];
        if (lane == 0) rr[row] = r;
    }
}
__device__ __forceinline__ void phase_final(const Ptrs& P, const bf16_t* hs, const float* ss, float* outp, int vcu, int G) {
    const int lane = threadIdx.x & 63, gw = vcu * NWAVES + (threadIdx.x >> 6), NGW = G * NWAVES;
    f32x4 gf[2][2];
#pragma unroll
    for (int j = 0; j < 2; ++j) { gf[j][0] = *((const f32x4*)(P.g_final + 512 * j + 8 * lane)); gf[j][1] = *((const f32x4*)(P.g_final + 512 * j + 8 * lane + 4)); }
    for (int row = gw; row < T; row += NGW) {
        const u32x4* h = (const u32x4*)(hs + (size_t)row * D) + lane; const float r = __builtin_amdgcn_rsqf(ss[row] * (1.f / D) + EPS);
        float* o = outp + (size_t)row * D + 8 * lane;
#pragma unroll
        for (int j = 0; j < 2; ++j) { float a[8]; unpack8(h[64 * j], a);
            f32x4 o0, o1; o0[0] = a[0] * r * gf[j][0][0]; o0[1] = a[1] * r * gf[j][0][1]; o0[2] = a[2] * r * gf[j][0][2]; o0[3] = a[3] * r * gf[j][0][3];
            o1[0] = a[4] * r * gf[j][1][0]; o1[1] = a[5] * r * gf[j][1][1]; o1[2] = a[6] * r * gf[j][1][2]; o1[3] = a[7] * r * gf[j][1][3];
            __builtin_nontemporal_store(o0, (f32x4*)(o + 512 * j)); __builtin_nontemporal_store(o1, (f32x4*)(o + 512 * j + 4)); }
    }
}
constexpr int AT_KSTR = 144, AT_VSTR = 520, AT_VOFF = 256 * AT_KSTR;
__device__ __forceinline__ int crow16(int reg, int h) { return (reg & 3) + 8 * (reg >> 2) + 4 * h; }
__device__ __forceinline__ void phase_attn(const Ptrs& P, LAS unsigned char* lds, int G) {
    const int tid = threadIdx.x, lane = tid & 63, wave = __builtin_amdgcn_readfirstlane(tid >> 6), r32 = lane & 31, hh = lane >> 5;
    const bf16_t* Qb = (const bf16_t*)(P.ws + WS_Q); const bf16_t* Kb = (const bf16_t*)(P.ws + WS_K); const bf16_t* Vb = (const bf16_t*)(P.ws + WS_V); bf16_t* Ob = (bf16_t*)(P.ws + WS_O);
    for (int unit = blockIdx.x; unit < 2 * 64 * 4; unit += G) {
        const int kh = unit & 3, nb = (unit >> 2) & 63, b = unit >> 8;
        const int tq0 = b * SEQ + nb * 128;
        __syncthreads();
        {
            const int key = tid >> 1, hf = tid & 1; const bool ok = (nb > 0) || (key >= 128);
            u32x4 kv[4], vv[4];
#pragma unroll
            for (int i = 0; i < 4; ++i) { kv[i] = (u32x4){0u, 0u, 0u, 0u}; vv[i] = (u32x4){0u, 0u, 0u, 0u}; }
            if (ok) { const size_t go = (size_t)(tq0 - 128 + key) * KD + kh * 64 + hf * 32;
#pragma unroll
                for (int i = 0; i < 4; ++i) { kv[i] = *(const u32x4*)(Kb + go + 8 * i); vv[i] = *(const u32x4*)(Vb + go + 8 * i); } }
#pragma unroll
            for (int i = 0; i < 4; ++i) *(LAS u32x4*)(lds + key * AT_KSTR + hf * 64 + 16 * i) = kv[i];
#pragma unroll
            for (int i = 0; i < 4; ++i)
#pragma unroll
                for (int e = 0; e < 4; ++e) { const unsigned w = vv[i][e]; const int d = hf * 32 + 8 * i + 2 * e;
                    *(LAS bf16_t*)(lds + AT_VOFF + d * AT_VSTR + key * 2) = (bf16_t)(w & 0xffffu); *(LAS bf16_t*)(lds + AT_VOFF + (d + 1) * AT_VSTR + key * 2) = (bf16_t)(w >> 16); }
        }
        __syncthreads();
        const int g = wave >> 1, head = kh * 4 + g; const float sink = P.sinks[head] * LOG2E;
        for (int qq = 0; qq < 2; ++qq) {
            const int qi = (wave & 1) * 2 + qq;
            const int tq = tq0 + qi * 32 + r32;
            bf16x8 qf[4];
#pragma unroll
            for (int s = 0; s < 4; ++s) qf[s] = *(const bf16x8*)(Qb + (size_t)tq * D + head * 64 + 16 * s + 8 * hh);
            f32x16 st[5];
#pragma unroll
            for (int kt = 0; kt < 5; ++kt) {
                f32x16 a;
#pragma unroll
                for (int i = 0; i < 16; ++i) a[i] = 0.f;
                const LAS unsigned char* kp = lds + (32 * (qi + kt) + r32) * AT_KSTR + 16 * hh;
#pragma unroll
                for (int s = 0; s < 4; ++s) { const bf16x8 kf = *(const LAS bf16x8*)(kp + 32 * s); a = __builtin_amdgcn_mfma_f32_32x32x16_bf16(kf, qf[s], a, 0, 0, 0); }
                st[kt] = a;
            }
            const int iq = qi * 32 + r32;
            float mx = sink;
#pragma unroll
            for (int kt = 0; kt < 5; ++kt)
#pragma unroll
                for (int i = 0; i < 16; ++i) { const int jb = 32 * (qi + kt) + crow16(i, hh); const bool valid = (jb > iq) && (jb <= iq + 128) && (nb > 0 || jb >= 128);
                    const float v = valid ? st[kt][i] : -1e30f; st[kt][i] = v; mx = fmaxf(mx, v); }
            mx = fmaxf(mx, __shfl_xor(mx, 32));
            float sum = 0.f;
#pragma unroll
            for (int kt = 0; kt < 5; ++kt)
#pragma unroll
                for (int i = 0; i < 16; ++i) { const float e = __builtin_amdgcn_exp2f(st[kt][i] - mx); st[kt][i] = e; sum += e; }
            sum += __shfl_xor(sum, 32);
            const float inv = 1.f / (sum + __builtin_amdgcn_exp2f(sink - mx));
            f32x16 o0, o1;
#pragma unroll
            for (int i = 0; i < 16; ++i) { o0[i] = 0.f; o1[i] = 0.f; }
#pragma unroll
            for (int kt = 0; kt < 5; ++kt)
#pragma unroll
                for (int s = 0; s < 2; ++s) {
                    u32x4 pw; pw.x = cvt_pk_bf16(st[kt][8 * s + 0], st[kt][8 * s + 1]); pw.y = cvt_pk_bf16(st[kt][8 * s + 2], st[kt][8 * s + 3]);
                    pw.z = cvt_pk_bf16(st[kt][8 * s + 4], st[kt][8 * s + 5]); pw.w = cvt_pk_bf16(st[kt][8 * s + 6], st[kt][8 * s + 7]);
                    const bf16x8 pf = __builtin_bit_cast(bf16x8, pw);
                    const int key0 = 32 * (qi + kt) + 16 * s + 4 * hh;
                    const LAS unsigned char* vp0 = lds + AT_VOFF + r32 * AT_VSTR + key0 * 2; const LAS unsigned char* vp1 = vp0 + 32 * AT_VSTR;
                    const s16x4 a00 = *(const LAS s16x4*)(vp0), a01 = *(const LAS s16x4*)(vp0 + 16), a10 = *(const LAS s16x4*)(vp1), a11 = *(const LAS s16x4*)(vp1 + 16);
                    const bf16x8 v0 = __builtin_shufflevector(a00, a01, 0, 1, 2, 3, 4, 5, 6, 7), v1 = __builtin_shufflevector(a10, a11, 0, 1, 2, 3, 4, 5, 6, 7);
                    o0 = __builtin_amdgcn_mfma_f32_32x32x16_bf16(v0, pf, o0, 0, 0, 0);
                    o1 = __builtin_amdgcn_mfma_f32_32x32x16_bf16(v1, pf, o1, 0, 0, 0);
                }
            bf16_t* op = Ob + (size_t)tq * D + head * 64 + 4 * hh;
#pragma unroll
            for (int gq = 0; gq < 4; ++gq) {
                u32x2 w0, w1; w0.x = cvt_pk_bf16(o0[4 * gq] * inv, o0[4 * gq + 1] * inv); w0.y = cvt_pk_bf16(o0[4 * gq + 2] * inv, o0[4 * gq + 3] * inv);
                w1.x = cvt_pk_bf16(o1[4 * gq] * inv, o1[4 * gq + 1] * inv); w1.y = cvt_pk_bf16(o1[4 * gq + 2] * inv, o1[4 * gq + 3] * inv);
                *(u32x2*)(op + 8 * gq) = w0; *(u32x2*)(op + 32 + 8 * gq) = w1;
            }
        }
    }
}

constexpr int NPHASE = 16;
struct Args { Ptrs P; int ph_lo, ph_hi; };
__global__ void __launch_bounds__(NTHREADS, 2) yoco_fwd(Args args) {
    extern __shared__ __attribute__((aligned(16))) unsigned char lds_raw[];
    LAS unsigned char* lds = (LAS unsigned char*)lds_raw;
    const Ptrs& P = args.P;
    const int tid = threadIdx.x, G = gridDim.x, bx = blockIdx.x;
    const int vcu = (G % 8 == 0) ? (bx % 8) * (G / 8) + bx / 8 : bx;
    volatile LAS unsigned* MISC = (volatile LAS unsigned*)(lds + MISC_OFF);
    if (tid < 4) MISC[tid] = 0u;
    __syncthreads();
    const int lo = args.ph_lo, hi = args.ph_hi;
    const bool multi = (hi - lo) > 1;
    XcdBarrier bar; bar.bar = (unsigned*)(P.ws + WS_CTL) + CW_BAR; bar.x = 0; bar.st = MISC;
    if (multi) bar = xcd_barrier_post((unsigned*)(P.ws + WS_CTL) + CW_BAR, MISC);
    bf16_t* HBA = (bf16_t*)(P.ws + WS_HBA); bf16_t* HBB = (bf16_t*)(P.ws + WS_HBB);
    LAS int* tt = (LAS int*)(lds + TT_OFF);
#ifdef ONLY_PH
#define IN(k) ((k) == ONLY_PH)
#else
#define IN(k) (lo <= (k) && (k) < hi)
#endif
#define SEAM(k) do { if (IN(k) && IN((k) + 1)) xcd_barrier(bar); } while (0)
#ifndef REPEAT_MASK
#define REPEAT_MASK 0u
#endif
#define REP(k) if ((REPEAT_MASK >> (k)) & 1u)
    float* const DRYH = (float*)(P.ws + 448 * MiB); bf16_t* const DRYB = (bf16_t*)(P.ws + 448 * MiB);
    unsigned* const CNT0 = (unsigned*)(P.ws + WS_CTL) + CW_CNT; unsigned* const LIST = (unsigned*)(P.ws + WS_LIST);
    float* const ROUT = (float*)(P.ws + WS_RX) + T; float* const R2 = (float*)(P.ws + WS_RX) + 4 * T;
    float* const SS3 = (float*)(P.ws + WS_CTL) + CW_SS3;
    bf16_t* const HsA = HBA; bf16_t* const HsB = HBB;
#define JB(J) J.P = P; J.G = G; J.c = bx
    if (IN(0)) { phase_prologue(P, lds, vcu, G); REP(0) { xcd_barrier(bar); phase_prologue(P, lds, vcu, G); } } SEAM(0);
    if (IN(1)) {
        REP(1) { { JobPool J; JB(J); J.hs = HsA; g8::gemm_phase(lds, J); } { JobUp J; JB(J); g8::gemm_phase(lds, J); } xcd_barrier(bar); }
        { JobPool J; JB(J); J.hs = HsA; g8::gemm_phase(lds, J); }
        { JobUp J; JB(J); g8::gemm_phase(lds, J); }
    } SEAM(1);
    if (IN(2)) { phase_router(P, 0, HsA, CNT0, LIST, ROUT, lds, G); REP(2) { xcd_barrier(bar); phase_router(P, 0, HsA, CNT0 + 128, (unsigned*)DRYH, (float*)DRYH + 32 * T, lds, G); } } SEAM(2);
    if (IN(3)) { build_tile_table(P, 0, tt); REP(3) { JobGateUp J; JB(J); J.l = 0; J.hb = HsA; J.tt = tt; J.rr = ROUT; g8::gemm_phase(lds, J); xcd_barrier(bar); }
                 JobGateUp J; JB(J); J.l = 0; J.hb = HsA; J.tt = tt; J.rr = ROUT; g8::gemm_phase(lds, J); } SEAM(3);
    if (IN(4)) { build_tile_table(P, 0, tt); REP(4) { JobDown J; JB(J); J.l = 0; J.tt = tt; g8::gemm_phase(lds, J); xcd_barrier(bar); }
                 JobDown J; JB(J); J.l = 0; J.tt = tt; g8::gemm_phase(lds, J); } SEAM(4);
    if (IN(5)) { REP(5) { phase_combine(P, HsA, DRYB, (float*)DRYH + 16 * T * 64, vcu, G); xcd_barrier(bar); } phase_combine(P, HsA, HsA, R2, vcu, G); } SEAM(5);
    if (IN(6)) { REP(6) { JobPle J; JB(J); J.l = 0; J.hs = HsA; J.hd = DRYB; J.rr = R2; J.ss = SS3 + 2 * T; g8::gemm_phase(lds, J); xcd_barrier(bar); }
                 JobPle J; JB(J); J.l = 0; J.hs = HsA; J.hd = HsB; J.rr = R2; J.ss = SS3; g8::gemm_phase(lds, J); } SEAM(6);
    if (IN(7)) { REP(7) { JobKvq J; JB(J); J.hb3 = HsB; J.ss3 = SS3; g8::gemm_phase(lds, J); xcd_barrier(bar); }
                 JobKvq J; JB(J); J.hb3 = HsB; J.ss3 = SS3; g8::gemm_phase(lds, J); } SEAM(7);
    if (IN(8)) { REP(8) { phase_attn(P, lds, G); __syncthreads(); xcd_barrier(bar); } phase_attn(P, lds, G); __syncthreads(); } SEAM(8);
    if (IN(9)) { REP(9) { JobOproj J; JB(J); J.hs = HsB; J.hd = DRYB; g8::gemm_phase(lds, J); xcd_barrier(bar); }
                 JobOproj J; JB(J); J.hs = HsB; J.hd = HsB; g8::gemm_phase(lds, J); } SEAM(9);
    if (IN(10)) { phase_router(P, 1, HsB, CNT0 + 64, LIST, ROUT, lds, G); REP(10) { xcd_barrier(bar); phase_router(P, 1, HsB, CNT0 + 192, (unsigned*)DRYH, (float*)DRYH + 32 * T, lds, G); } } SEAM(10);
    if (IN(11)) { build_tile_table(P, 1, tt); REP(11) { JobGateUp J; JB(J); J.l = 1; J.hb = HsB; J.tt = tt; J.rr = ROUT; g8::gemm_phase(lds, J); xcd_barrier(bar); }
                  JobGateUp J; JB(J); J.l = 1; J.hb = HsB; J.tt = tt; J.rr = ROUT; g8::gemm_phase(lds, J); } SEAM(11);
    if (IN(12)) { build_tile_table(P, 1, tt); REP(12) { JobDown J; JB(J); J.l = 1; J.tt = tt; g8::gemm_phase(lds, J); xcd_barrier(bar); }
                  JobDown J; JB(J); J.l = 1; J.tt = tt; g8::gemm_phase(lds, J); } SEAM(12);
    if (IN(13)) { REP(13) { phase_combine(P, HsB, DRYB, (float*)DRYH + 16 * T * 64, vcu, G); xcd_barrier(bar); } phase_combine(P, HsB, HsB, R2, vcu, G); } SEAM(13);
    if (IN(14)) { REP(14) { JobPle J; JB(J); J.l = 1; J.hs = HsB; J.hd = DRYB; J.rr = R2; J.ss = SS3 + 2 * T; g8::gemm_phase(lds, J); xcd_barrier(bar); }
                  JobPle J; JB(J); J.l = 1; J.hs = HsB; J.hd = HsA; J.rr = R2; J.ss = SS3 + T; g8::gemm_phase(lds, J); } SEAM(14);
    if (IN(15)) { REP(15) { phase_final(P, HsA, SS3 + T, DRYH, vcu, G); xcd_barrier(bar); } phase_final(P, HsA, SS3 + T, P.out, vcu, G); }
#undef JB
#undef IN
#undef SEAM
}
#ifndef HYBRID
#define HYBRID 0
#endif
#ifndef NAIVE_MASK
#define NAIVE_MASK 0u
#endif
extern "C" void kernel_launch(void* const* d_in, const int* in_sizes, int n_in, void* d_out, int out_size, void* d_ws, size_t ws_size, hipStream_t stream) {
    static int grid = 0;
    if (grid == 0) {
        if (n_in != 24 || in_sizes[0] != T * D || out_size != T * D || ws_size < WS_END) { fprintf(stderr, "kernel_launch: unexpected problem (n_in %d, ws %zu)\n", n_in, ws_size); grid = -1; return; }
        int dev = 0, cus = 0, per_cu = 0;
        if (hipGetDevice(&dev) != hipSuccess || hipDeviceGetAttribute(&cus, hipDeviceAttributeMultiprocessorCount, dev) != hipSuccess) { grid = -1; return; }
        if (hipFuncSetAttribute((const void*)yoco_fwd, hipFuncAttributeMaxDynamicSharedMemorySize, LDS_BYTES) != hipSuccess) { fprintf(stderr, "kernel_launch: hipFuncSetAttribute failed\n"); grid = -1; return; }
        if (hipOccupancyMaxActiveBlocksPerMultiprocessor(&per_cu, (const void*)yoco_fwd, NTHREADS, LDS_BYTES) != hipSuccess || per_cu < 1) { fprintf(stderr, "kernel_launch: occupancy query says %d\n", per_cu); }
        (void)hipGetLastError();
        grid = cus;
    }
    if (grid < 0) return;
    Ptrs P; memset(&P, 0, sizeof P);
    P.x = (const float*)d_in[0]; P.p = (const float*)d_in[1]; P.pos = (const int*)d_in[2]; P.g_mix = (const float*)d_in[3]; P.g_ffn = (const float*)d_in[4];
    P.pool_w = (const float*)d_in[5]; P.pool_scale = (const float*)d_in[6]; P.g_kv = (const float*)d_in[7]; P.w_k = (const float*)d_in[8]; P.w_v = (const float*)d_in[9];
    P.w_q = (const float*)d_in[10]; P.w_o = (const float*)d_in[11]; P.sinks = (const float*)d_in[12]; P.w_gr = (const float*)d_in[13]; P.b_gr = (const float*)d_in[14];
    P.w_er = (const float*)d_in[15]; P.b_er = (const float*)d_in[16]; P.w_eg = (const float*)d_in[17]; P.w_eu = (const float*)d_in[18]; P.w_ed = (const float*)d_in[19];
    P.g_ple = (const float*)d_in[20]; P.w_pg = (const float*)d_in[21]; P.w_pu = (const float*)d_in[22]; P.g_final = (const float*)d_in[23];
    P.out = (float*)d_out; P.ws = (unsigned char*)d_ws;
    (void)hipMemsetAsync(P.ws + WS_CTL, 0, 1 * MiB, stream);
    Args a; memset(&a, 0, sizeof a); a.P = P;
    a.ph_lo = 0; a.ph_hi = NPHASE;
    hipLaunchKernelGGL(yoco_fwd, dim3(grid), dim3(NTHREADS), LDS_BYTES, stream, a);
}
```

```cpp
#define HYBRID 0
#define NAIVE_MASK 0u
#define REPEAT_MASK 0u
#include <hip/hip_runtime.h>
#include <cstdio>
#include <cstdint>
#include <cstring>

#define LAS __attribute__((address_space(3)))
typedef unsigned short bf16_t;
typedef short bf16x8 __attribute__((ext_vector_type(8)));
typedef short s16x4 __attribute__((ext_vector_type(4)));
typedef float f32x2 __attribute__((ext_vector_type(2)));
typedef float f32x4 __attribute__((ext_vector_type(4)));
typedef float f32x16 __attribute__((ext_vector_type(16)));
typedef unsigned u32x2 __attribute__((ext_vector_type(2)));
typedef unsigned u32x4 __attribute__((ext_vector_type(4)));

constexpr int T = 16384, D = 1024, SEQ = 8192, NE = 32, DE = 512, PD = 256, HD = 64, NQH = 16, NKVH = 4, KD = 256;
constexpr float EPS = 1e-6f;
constexpr float LOG2E = 1.4426950408889634f;
constexpr float QSCALE = 0.125f * LOG2E;
constexpr int NTHREADS = 512, NWAVES = 8;

__device__ __forceinline__ bf16_t f2bf(float f) { unsigned u = __float_as_uint(f); u += 0x7fffu + ((u >> 16) & 1u); return (bf16_t)(u >> 16); }
__device__ __forceinline__ float bf2f(bf16_t b) { return __uint_as_float(((unsigned)b) << 16); }
__device__ __forceinline__ unsigned cvt_pk_bf16(float lo, float hi) { unsigned r; asm volatile("v_cvt_pk_bf16_f32 %0, %1, %2" : "=v"(r) : "v"(lo), "v"(hi)); return r; }
__device__ __forceinline__ float wave_sum(float v) {
#pragma unroll
    for (int o = 1; o < 64; o <<= 1) v += __shfl_xor(v, o);
    return v;
}
__device__ __forceinline__ float fast_sigmoid(float x) { return __builtin_amdgcn_rcpf(1.f + __builtin_amdgcn_exp2f(-x * LOG2E)); }

constexpr size_t MiB = 1u << 20;
constexpr size_t WS_CTL = 0;
constexpr size_t WS_CS = 1 * MiB;
constexpr size_t WS_RX = 5 * MiB;
constexpr size_t WS_LIST = 6 * MiB;
constexpr size_t WS_U = 8 * MiB;
constexpr size_t WS_HBA = 72 * MiB;
constexpr size_t WS_HBB = 104 * MiB;
constexpr size_t WS_ACT = 136 * MiB;
constexpr size_t WS_Y = 176 * MiB;
constexpr size_t WS_W = 240 * MiB;
constexpr size_t WS_P16 = WS_ACT;
constexpr size_t WS_D16 = WS_Y;
constexpr size_t WS_Q = WS_Y;
constexpr size_t WS_O = WS_Y + 32 * MiB;
constexpr size_t WS_K = WS_ACT;
constexpr size_t WS_V = WS_ACT + 8 * MiB;
constexpr size_t WW_GU = 0;
constexpr size_t WW_DN = 128 * MiB;
constexpr size_t WW_PLEG = 192 * MiB;
constexpr size_t WW_PLEU = 196 * MiB;
constexpr size_t WW_KVQ = 197 * MiB;
constexpr size_t WW_WO = 200 * MiB;
constexpr size_t WW_POOL = 202 * MiB;
constexpr size_t WW_WR = 203 * MiB;
constexpr size_t WS_END = WS_W + 204 * MiB;
constexpr int CW_BAR = 4096;
constexpr int CW_CNT = 8192;
constexpr int CW_Q = 9216;
constexpr int CW_ARR = 10240;

struct Ptrs {
    const float *x, *p; const int* pos; const float *g_mix, *g_ffn, *pool_w, *pool_scale, *g_kv, *w_k, *w_v, *w_q, *w_o, *sinks,
        *w_gr, *b_gr, *w_er, *b_er, *w_eg, *w_eu, *w_ed, *g_ple, *w_pg, *w_pu, *g_final;
    float* out; unsigned char* ws;
};

#define XB_TMO      128
#define XB_XCNT(j)  (256  + 64 * (j))
#define XB_XSUB(j)  (1280 + 64 * (j))
#define XB_XGEN(j)  (2304 + 64 * (j))
#define XB_TOP      3328
#define XB_TOPGEN   3392
#define XCD_BAR_WORDS 3456
#define XB_SPIN_CAP (1u << 18)
__device__ __forceinline__ unsigned xb_ld(unsigned* p)              { return __hip_atomic_load(p, __ATOMIC_RELAXED, __HIP_MEMORY_SCOPE_AGENT); }
__device__ __forceinline__ unsigned xb_add(unsigned* p, unsigned v) { return __hip_atomic_fetch_add(p, v, __ATOMIC_RELAXED, __HIP_MEMORY_SCOPE_AGENT); }
__device__ __forceinline__ unsigned xb_xcc_id() { return (unsigned)__builtin_amdgcn_s_getreg((3 << 11) | 20) & 0xFu; }
#define XB_SPIN(cond, bar) do { unsigned _sp = 0; while (cond) { __builtin_amdgcn_s_sleep(1); \
    if ((++_sp & 255u) == 0u) { if (xb_ld(&(bar)[XB_TMO])) break; if (_sp > XB_SPIN_CAP) { atomicAdd(&(bar)[XB_TMO], 1u); break; } } } } while (0)
struct XcdBarrier { unsigned* bar; unsigned x; volatile LAS unsigned* st; };
__device__ __forceinline__ XcdBarrier xcd_barrier_post(unsigned* bar, volatile LAS unsigned* st) {
    XcdBarrier b; b.bar = bar; b.x = xb_xcc_id(); b.st = st;
    if (threadIdx.x == 0) (void)xb_add(&bar[XB_XCNT(b.x)], 1u);
    return b;
}
__device__ __forceinline__ void xcd_barrier_complete(unsigned* bar, unsigned x, unsigned& nloc, unsigned& nx) {
    const unsigned G = gridDim.x * gridDim.y * gridDim.z;
    unsigned sum, cnt, mine, sp = 0u;
    for (;;) {
        sum = 0u; cnt = 0u; mine = 0u;
#pragma unroll
        for (unsigned j = 0; j < 16; ++j) { const unsigned c = xb_ld(&bar[XB_XCNT(j)]); sum += c; cnt += (c > 0u) ? 1u : 0u; mine = (j == x) ? c : mine; }
        if (sum == G) break;
        __builtin_amdgcn_s_sleep(1);
        if ((++sp & 255u) == 0u) { if (xb_ld(&bar[XB_TMO])) break; if (sp > XB_SPIN_CAP) { atomicAdd(&bar[XB_TMO], 1u); break; } }
    }
    nloc = mine > 0u ? mine : 1u; nx = cnt > 0u ? cnt : 1u;
}
__device__ __forceinline__ void xcd_barrier(const XcdBarrier& b) {
    asm volatile("s_waitcnt vmcnt(0)" ::: "memory");
    __syncthreads();
    if (threadIdx.x == 0) {
        unsigned* bar = b.bar;
        __builtin_amdgcn_s_waitcnt(0);
        unsigned nloc = b.st[0], nx = b.st[1];
        if (nloc == 0u) { xcd_barrier_complete(bar, b.x, nloc, nx); b.st[0] = nloc; b.st[1] = nx; }
        const unsigned old = xb_add(&bar[XB_XSUB(b.x)], 1u);
        const unsigned gen = old / nloc;
        if (old + 1u == (gen + 1u) * nloc) {
            __builtin_amdgcn_fence(__ATOMIC_RELEASE, "agent");
            asm volatile("s_waitcnt vmcnt(0)" ::: "memory");
            const unsigned og = xb_add(&bar[XB_TOP], 1u);
            const unsigned tg = og / nx;
            if (og + 1u == (tg + 1u) * nx) xb_add(&bar[XB_TOPGEN], 1u);
            else XB_SPIN(xb_ld(&bar[XB_TOPGEN]) == tg, bar);
            __builtin_amdgcn_fence(__ATOMIC_ACQUIRE, "agent");
            xb_add(&bar[XB_XGEN(b.x)], 1u);
            asm volatile("s_waitcnt vmcnt(0)" ::: "memory");
        } else {
            XB_SPIN(xb_ld(&bar[XB_XGEN(b.x)]) == gen, bar);
            __builtin_amdgcn_fence(__ATOMIC_ACQUIRE, "agent");
            asm volatile("s_waitcnt vmcnt(0)" ::: "memory");
        }
    }
    __syncthreads();
}

constexpr int RING_BYTES = 131072;
constexpr int MISC_OFF = RING_BYTES;
constexpr int TT_OFF = RING_BYTES + 256;
constexpr int RED_OFF = RING_BYTES + 2048;
constexpr int LDS_BYTES = 147456;

namespace g8 {
constexpr int BM = 256, BK = 64, HALF = 128, HTB = HALF * BK * 2, NXCD = 8, WGM = 8;
__device__ __forceinline__ int lds_byte(int r, int c) { const int st = (r >> 4) * 2 + (c >> 5), rr = r & 15, cc = c & 31, ob = rr * 64 + cc * 2; return st * 1024 + (ob ^ (((ob >> 9) & 1) << 5)); }
__device__ __forceinline__ void stage_rc(int b, int& R, int& C) { const int st = b / 1024, sb = b % 1024, swz = sb ^ (((sb >> 9) & 1) << 5); R = (st >> 1) * 16 + swz / 64; C = (st & 1) * 32 + (swz % 64) / 2; }
__device__ __forceinline__ int perm32(int rho) { const int n = rho >> 4, i = rho & 15; return 8 * (i >> 2) + 4 * n + (i & 3); }
__device__ __forceinline__ int xcd_remap(int L, int nwg) { const int q = nwg / NXCD, r = nwg % NXCD, xcd = L % NXCD, off = L / NXCD; return (xcd < r ? xcd * (q + 1) : r * (q + 1) + (xcd - r) * q) + off; }
__device__ __forceinline__ bool dense_unit(int i, int G, int c, int nM, int nN, int& pm, int& pn) {
    const int nwg = nM * nN; const long L = (long)i * G + c; if (L >= nwg) return false;
    const int wgid = xcd_remap((int)L, nwg);
    const int nig = WGM * nN, gid = wgid / nig, fm = gid * WGM, gsz = (nM - fm) < WGM ? (nM - fm) : WGM;
    pm = fm + ((wgid % nig) % gsz); pn = (wgid % nig) / gsz; return true;
}

template <class Job>
__device__ __forceinline__ void gemm_phase(LAS unsigned char* lds, Job& J) {
    typedef typename Job::Unit Unit;
    constexpr int K = Job::K, nt = K / BK;
    static_assert(nt >= 4 && (nt % 2) == 0, "K must be a multiple of 128, >= 256");
    const int tid = threadIdx.x, wid = __builtin_amdgcn_readfirstlane(tid >> 6), lane = tid & 63, wr = wid >> 2, wc = wid & 3, fr = lane & 15, fq = lane >> 4;
    unsigned voffB[2];
#pragma unroll
    for (int i = 0; i < 2; ++i) { int R, C; stage_rc(tid * 16 + i * 8192, R, C); const int Rb = Job::PERM ? ((R & ~31) + perm32(R & 31)) : R; voffB[i] = (unsigned)(Rb * K + C) * 2u; }
    constexpr size_t kstep = (size_t)(BK * 2);
    constexpr size_t hstepB = (size_t)HALF * K * 2;
    const unsigned ldsw = (unsigned)wid * 1024u;
    const int aoff = lds_byte(wr * 64 + fr, fq * 8), boff = lds_byte(wc * 32 + fr, fq * 8);
#define G8_SA(b, h) (((b) * 2 + (h)) * HTB)
#define G8_SB(b, h) ((4 + (b) * 2 + (h)) * HTB)
#define G8_STAGE_B(bufoff, gbase) do { _Pragma("unroll") for (int _i = 0; _i < 2; ++_i) \
        __builtin_amdgcn_global_load_lds((const unsigned*)((const char*)(gbase) + voffB[_i]), (LAS unsigned*)(lds + (bufoff) + ldsw + _i * 8192), 16, 0, 0); } while (0)
#define G8_STAGE_A(bufoff, gbase, off2) do { _Pragma("unroll") for (int _i = 0; _i < 2; ++_i) \
        __builtin_amdgcn_global_load_lds((const unsigned*)((const char*)(gbase) + (off2)[_i]), (LAS unsigned*)(lds + (bufoff) + ldsw + _i * 8192), 16, 0, 0); } while (0)
#define G8_LDA(dst, b, h) do { _Pragma("unroll") for (int m = 0; m < 4; ++m) _Pragma("unroll") for (int k = 0; k < 2; ++k) dst[m][k] = *(const LAS bf16x8*)(lds + G8_SA(b, h) + aoff + m * 2048 + k * 1024); } while (0)
#define G8_LDB(dst, b, h) do { _Pragma("unroll") for (int n = 0; n < 2; ++n) _Pragma("unroll") for (int k = 0; k < 2; ++k) dst[n][k] = *(const LAS bf16x8*)(lds + G8_SB(b, h) + boff + n * 2048 + k * 1024); } while (0)
#define G8_MMA(ai, bj, At, Bt) do { __builtin_amdgcn_s_setprio(1); _Pragma("unroll") for (int m = 0; m < 4; ++m) _Pragma("unroll") for (int n = 0; n < 2; ++n) _Pragma("unroll") for (int k = 0; k < 2; ++k) \
        acc[ai][bj][m][n] = __builtin_amdgcn_mfma_f32_16x16x32_bf16(Bt[n][k], At[m][k], acc[ai][bj][m][n], 0, 0, 0); __builtin_amdgcn_s_setprio(0); } while (0)
#define G8_WAIT_V(n) asm volatile("s_waitcnt vmcnt(" #n ")" ::: "memory")
#define G8_WAIT_L(n) asm volatile("s_waitcnt lgkmcnt(" #n ")" ::: "memory")
#define G8_BAR __builtin_amdgcn_s_barrier()
#define G8_SCHED __builtin_amdgcn_sched_barrier(0)
    Unit cur, nxt; int ui = 0;
    if (!J.next(0, cur)) return;
    unsigned ao[2][2], no[2][2];
    { int tid_ = tid; asm volatile("" : "+v"(tid_)); J.a_offs(cur, tid_, ao); }
    f32x4 acc[2][2][4][2];
#pragma unroll
    for (int a = 0; a < 2; ++a)
#pragma unroll
        for (int b = 0; b < 2; ++b)
#pragma unroll
            for (int m = 0; m < 4; ++m)
#pragma unroll
                for (int n = 0; n < 2; ++n) acc[a][b][m][n] = (f32x4){0.f, 0.f, 0.f, 0.f};
    bf16x8 At[4][2], B0[2][2], B1[2][2];
    const char* cA = J.a_base(cur); const char* cB = J.b_base(cur);
    G8_STAGE_B(G8_SB(0, 0), cB); G8_STAGE_B(G8_SB(0, 1), cB + hstepB); G8_STAGE_A(G8_SA(0, 0), cA, ao[0]); G8_STAGE_A(G8_SA(0, 1), cA, ao[1]);
    if (wr == 1) G8_BAR;
    G8_WAIT_V(2); G8_BAR;
    G8_STAGE_B(G8_SB(1, 0), cB + kstep); G8_STAGE_A(G8_SA(1, 0), cA + kstep, ao[0]); G8_STAGE_B(G8_SB(1, 1), cB + hstepB + kstep);
    G8_WAIT_V(6); G8_BAR;
    for (;;) {
        const bool has_next = J.next(ui + 1, nxt);
        const char* nA = cA; const char* nB = cB;
#pragma unroll
        for (int h = 0; h < 2; ++h)
#pragma unroll
            for (int i = 0; i < 2; ++i) no[h][i] = ao[h][i];
        if (has_next) { nA = J.a_base(nxt); nB = J.b_base(nxt); int tid_ = tid; asm volatile("" : "+v"(tid_)); J.a_offs(nxt, tid_, no); }
#pragma unroll 1
        for (int t = 0; t < nt; t += 2) {
            const bool last = (t == nt - 2);
            const char* a1 = cA + (size_t)(t + 1) * kstep;
            const char* a2 = last ? nA : cA + (size_t)(t + 2) * kstep; const char* b2 = last ? nB : cB + (size_t)(t + 2) * kstep;
            const char* a3 = a2 + kstep; const char* b3 = b2 + kstep;
            unsigned o2[2][2];
#pragma unroll
            for (int h = 0; h < 2; ++h)
#pragma unroll
                for (int i = 0; i < 2; ++i) o2[h][i] = last ? no[h][i] : ao[h][i];
            G8_LDB(B0, 0, 0); G8_LDB(B1, 0, 1); G8_SCHED; G8_LDA(At, 0, 0); G8_STAGE_A(G8_SA(1, 1), a1, ao[1]);
            G8_WAIT_V(8); G8_WAIT_L(0); G8_BAR; G8_MMA(0, 0, At, B0); G8_MMA(0, 1, At, B1); G8_BAR; G8_SCHED;
            G8_LDA(At, 0, 1); G8_STAGE_B(G8_SB(0, 0), b2); G8_STAGE_B(G8_SB(0, 1), b2 + hstepB); G8_STAGE_A(G8_SA(0, 0), a2, o2[0]);
            G8_WAIT_V(8); G8_WAIT_L(0); G8_BAR; G8_MMA(1, 0, At, B0); G8_MMA(1, 1, At, B1); G8_BAR; G8_SCHED;
            G8_LDB(B0, 1, 0); G8_LDB(B1, 1, 1); G8_SCHED; G8_LDA(At, 1, 0); G8_STAGE_A(G8_SA(0, 1), a2, o2[1]);
            G8_WAIT_V(8); G8_WAIT_L(0); G8_BAR; G8_MMA(0, 0, At, B0); G8_MMA(0, 1, At, B1); G8_BAR; G8_SCHED;
            G8_LDA(At, 1, 1); G8_STAGE_B(G8_SB(1, 0), b3); G8_STAGE_B(G8_SB(1, 1), b3 + hstepB); G8_STAGE_A(G8_SA(1, 0), a3, o2[0]);
            G8_WAIT_V(8); G8_WAIT_L(0); G8_BAR; G8_MMA(1, 0, At, B0); G8_MMA(1, 1, At, B1); G8_BAR; G8_SCHED;
        }
        if (wr == 0) G8_BAR;
        { int fr_ = fr, fq_ = fq; asm volatile("" : "+v"(fr_), "+v"(fq_)); J.epi(acc, cur, wr, wc, fr_, fq_); }
        if (!has_next) break;
#pragma unroll
        for (int a = 0; a < 2; ++a)
#pragma unroll
            for (int b = 0; b < 2; ++b)
#pragma unroll
                for (int m = 0; m < 4; ++m)
#pragma unroll
                    for (int n = 0; n < 2; ++n) acc[a][b][m][n] = (f32x4){0.f, 0.f, 0.f, 0.f};
        cur = nxt; cA = nA; cB = nB; ++ui;
#pragma unroll
        for (int h = 0; h < 2; ++h)
#pragma unroll
            for (int i = 0; i < 2; ++i) ao[h][i] = no[h][i];
        if (wr == 1) G8_BAR;
    }
    G8_WAIT_V(0);
    G8_BAR;
#undef G8_SA
#undef G8_SB
#undef G8_STAGE_A
#undef G8_STAGE_B
#undef G8_LDA
#undef G8_LDB
#undef G8_MMA
#undef G8_WAIT_V
#undef G8_WAIT_L
#undef G8_BAR
#undef G8_SCHED
}
}
struct JobBase { Ptrs P; int G, c; };

__device__ __forceinline__ void dense_offs(int lda, int tid, unsigned (&o)[2][2]) {
#pragma unroll
    for (int i = 0; i < 2; ++i) { int R, C; g8::stage_rc(tid * 16 + i * 8192, R, C);
#pragma unroll
        for (int h = 0; h < 2; ++h) o[h][i] = (unsigned)((h * 128 + R) * lda + C) * 2u; }
}

struct JobPool : JobBase {
    static constexpr int K = 256; static constexpr bool PERM = true;
    struct Unit { int pm, pn; };
    bf16_t* hs;
    __device__ __forceinline__ bool next(int i, Unit& u) const { return g8::dense_unit(i, G, c, T / 256, 4, u.pm, u.pn); }
    __device__ __forceinline__ const char* a_base(const Unit& u) const { return (const char*)(P.ws + WS_D16) + ((size_t)u.pm * 256 * D + u.pn * 256) * 2; }
    __device__ __forceinline__ const char* b_base(const Unit& u) const { return (const char*)(P.ws + WS_W + WW_POOL) + (size_t)u.pn * 256 * 256 * 2; }
    __device__ __forceinline__ void a_offs(const Unit&, int tid, unsigned (&o)[2][2]) const { dense_offs(D, tid, o); }
    __device__ __forceinline__ void epi(const f32x4 (&acc)[2][2][4][2], const Unit& u, int wr, int wc, int fr, int fq) const {
        const int row0 = u.pm * 256 + wr * 64 + fr, col0 = u.pn * 256 + wc * 32 + 8 * fq;
#pragma unroll
        for (int ai = 0; ai < 2; ++ai) {
            f32x4 xv[4][2][2];
#pragma unroll
            for (int m = 0; m < 4; ++m) { const size_t ro = (size_t)(row0 + ai * 128 + m * 16) * D + col0;
#pragma unroll
                for (int bj = 0; bj < 2; ++bj)
#pragma unroll
                    for (int n = 0; n < 2; ++n) xv[m][bj][n] = __builtin_nontemporal_load((const f32x4*)(P.x + ro + bj * 128 + n * 4)); }
#pragma unroll
            for (int m = 0; m < 4; ++m) { const size_t ro = (size_t)(row0 + ai * 128 + m * 16) * D + col0;
#pragma unroll
                for (int bj = 0; bj < 2; ++bj) { const f32x4 v0 = xv[m][bj][0] + acc[ai][bj][m][0], v1 = xv[m][bj][1] + acc[ai][bj][m][1];
                    u32x4 w; w.x = cvt_pk_bf16(v0[0], v0[1]); w.y = cvt_pk_bf16(v0[2], v0[3]); w.z = cvt_pk_bf16(v1[0], v1[1]); w.w = cvt_pk_bf16(v1[2], v1[3]);
                    *(u32x4*)(hs + ro + bj * 128) = w; } }
        }
    }
};
struct JobUp : JobBase {
    static constexpr int K = 256; static constexpr bool PERM = true;
    struct Unit { int l, pm, pn; };
    __device__ __forceinline__ bool next(int i, Unit& u) const { int pm2; if (!g8::dense_unit(i, G, c, 2 * T / 256, 4, pm2, u.pn)) return false; u.l = pm2 >> 6; u.pm = pm2 & 63; return true; }
    __device__ __forceinline__ const char* a_base(const Unit& u) const { return (const char*)(P.ws + WS_P16) + ((size_t)u.l * T + (size_t)u.pm * 256) * PD * 2; }
    __device__ __forceinline__ const char* b_base(const Unit& u) const { return (const char*)(P.ws + WS_W + WW_PLEU) + ((size_t)u.l * D + (size_t)u.pn * 256) * PD * 2; }
    __device__ __forceinline__ void a_offs(const Unit&, int tid, unsigned (&o)[2][2]) const { dense_offs(PD, tid, o); }
    __device__ __forceinline__ void epi(const f32x4 (&acc)[2][2][4][2], const Unit& u, int wr, int wc, int fr, int fq) const {
        bf16_t* Ub = (bf16_t*)(P.ws + WS_U) + (size_t)u.l * T * D;
        const int row0 = u.pm * 256 + wr * 64 + fr, col0 = u.pn * 256 + wc * 32 + 8 * fq;
#pragma unroll
        for (int ai = 0; ai < 2; ++ai)
#pragma unroll
            for (int m = 0; m < 4; ++m) { bf16_t* rowp = Ub + (size_t)(row0 + ai * 128 + m * 16) * D + col0;
#pragma unroll
                for (int bj = 0; bj < 2; ++bj) { const f32x4 v0 = acc[ai][bj][m][0], v1 = acc[ai][bj][m][1];
                    u32x4 w; w.x = cvt_pk_bf16(v0[0], v0[1]); w.y = cvt_pk_bf16(v0[2], v0[3]); w.z = cvt_pk_bf16(v1[0], v1[1]); w.w = cvt_pk_bf16(v1[2], v1[3]);
                    *(u32x4*)(rowp + bj * 128) = w; } }
    }
};
__device__ __forceinline__ void build_tile_table(const Ptrs& P, int l, LAS int* tt) {
    const unsigned* cnt = (const unsigned*)(P.ws + WS_CTL) + CW_CNT + 64 * l;
    const int t = threadIdx.x;
    if (t < 161) {
        int tb = 0, lb = -1, nv = 0;
        for (int e = 0; e < NE; ++e) { const int ce = (int)cnt[e], ntl = (ce + 255) >> 8;
            if (t < 160 && t >= tb && t < tb + ntl) { const int j = t - tb; lb = e * T + 256 * j; nv = ce - 256 * j; if (nv > 256) nv = 256; }
            tb += ntl; }
        if (t == 160) tt[0] = tb; else { tt[1 + 2 * t] = lb; tt[2 + 2 * t] = nv; }
    }
    __syncthreads();
}
struct MoeUnit { int tile, pn, lb, nv; };
__device__ __forceinline__ bool moe_unit(int i, int G, int c, const LAS int* tt, MoeUnit& u) {
    const int ntiles = __builtin_amdgcn_readfirstlane(tt[0]); const int nwg = ntiles * 4;
    const long L = (long)i * G + c; if (L >= nwg) return false;
    const int v = g8::xcd_remap((int)L, nwg);
    u.tile = v >> 2; u.pn = v & 3; u.lb = __builtin_amdgcn_readfirstlane(tt[1 + 2 * u.tile]); u.nv = __builtin_amdgcn_readfirstlane(tt[2 + 2 * u.tile]); return true;
}
struct JobGateUp : JobBase {
    static constexpr int K = 1024; static constexpr bool PERM = true;
    typedef MoeUnit Unit;
    int l; const bf16_t* hb; const LAS int* tt; const float* rr;
    __device__ __forceinline__ bool next(int i, Unit& u) const { return moe_unit(i, G, c, tt, u); }
    __device__ __forceinline__ const char* a_base(const Unit&) const { return (const char*)hb; }
    __device__ __forceinline__ const char* b_base(const Unit& u) const { const int e = u.lb >> 14; return (const char*)(P.ws + WS_W + WW_GU) + (((size_t)l * NE + e) * 1024 + (size_t)u.pn * 256) * 1024 * 2; }
    __device__ __forceinline__ void a_offs(const Unit& u, int tid, unsigned (&o)[2][2]) const {
        const unsigned* list = (const unsigned*)(P.ws + WS_LIST) + u.lb;
#pragma unroll
        for (int i = 0; i < 2; ++i) { int R, C; g8::stage_rc(tid * 16 + i * 8192, R, C);
#pragma unroll
            for (int h = 0; h < 2; ++h) { int rt = h * 128 + R; rt = rt < u.nv ? rt : u.nv - 1; const unsigned en = list[rt]; o[h][i] = (en >> 1) * (unsigned)(D * 2) + (unsigned)C * 2u; } }
    }
    __device__ __forceinline__ void epi(const f32x4 (&acc)[2][2][4][2], const Unit& u, int wr, int wc, int fr, int fq) const {
        const unsigned* list = (const unsigned*)(P.ws + WS_LIST) + u.lb; const float* gwv = rr + T;
        bf16_t* act = (bf16_t*)(P.ws + WS_ACT) + (size_t)u.tile * 256 * DE + u.pn * 128 + wc * 32 + 8 * fq;
        unsigned en[2][4]; float rv[2][4], gv[2][4];
#pragma unroll
        for (int ai = 0; ai < 2; ++ai)
#pragma unroll
            for (int m = 0; m < 4; ++m) { const int rt = ai * 128 + wr * 64 + m * 16 + fr; const int rc = rt < u.nv ? rt : u.nv - 1; en[ai][m] = list[rc]; }
#pragma unroll
        for (int ai = 0; ai < 2; ++ai)
#pragma unroll
            for (int m = 0; m < 4; ++m) { rv[ai][m] = rr[en[ai][m] >> 1]; gv[ai][m] = gwv[en[ai][m]]; }
#pragma unroll
        for (int ai = 0; ai < 2; ++ai)
#pragma unroll
            for (int m = 0; m < 4; ++m) { const int rt = ai * 128 + wr * 64 + m * 16 + fr; const float r = rv[ai][m], gw = gv[ai][m];
                float o[8];
#pragma unroll
                for (int n = 0; n < 2; ++n)
#pragma unroll
                    for (int j = 0; j < 4; ++j) { const float g = acc[ai][0][m][n][j] * r, up = acc[ai][1][m][n][j] * r; o[n * 4 + j] = gw * g * fast_sigmoid(g) * up; }
                u32x4 w; w.x = cvt_pk_bf16(o[0], o[1]); w.y = cvt_pk_bf16(o[2], o[3]); w.z = cvt_pk_bf16(o[4], o[5]); w.w = cvt_pk_bf16(o[6], o[7]);
                *(u32x4*)(act + (size_t)rt * DE) = w; }
    }
};
struct JobDown : JobBase {
    static constexpr int K = 512; static constexpr bool PERM = true;
    typedef MoeUnit Unit;
    int l; const LAS int* tt;
    __device__ __forceinline__ bool next(int i, Unit& u) const { return moe_unit(i, G, c, tt, u); }
    __device__ __forceinline__ const char* a_base(const Unit& u) const { return (const char*)(P.ws + WS_ACT) + (size_t)u.tile * 256 * DE * 2; }
    __device__ __forceinline__ const char* b_base(const Unit& u) const { const int e = u.lb >> 14; return (const char*)(P.ws + WS_W + WW_DN) + (((size_t)l * NE + e) * 1024 + (size_t)u.pn * 256) * DE * 2; }
    __device__ __forceinline__ void a_offs(const Unit&, int tid, unsigned (&o)[2][2]) const { dense_offs(DE, tid, o); }
    __device__ __forceinline__ void epi(const f32x4 (&acc)[2][2][4][2], const Unit& u, int wr, int wc, int fr, int fq) const {
        const unsigned* list = (const unsigned*)(P.ws + WS_LIST) + u.lb;
        bf16_t* Y = (bf16_t*)(P.ws + WS_Y) + u.pn * 256 + wc * 32 + 8 * fq;
        unsigned en[2][4];
#pragma unroll
        for (int ai = 0; ai < 2; ++ai)
#pragma unroll
            for (int m = 0; m < 4; ++m) { const int rt = ai * 128 + wr * 64 + m * 16 + fr; en[ai][m] = list[rt < u.nv ? rt : u.nv - 1]; }
#pragma unroll
        for (int ai = 0; ai < 2; ++ai)
#pragma unroll
            for (int m = 0; m < 4; ++m) { const int rt = ai * 128 + wr * 64 + m * 16 + fr;
                if (rt < u.nv) { bf16_t* rowp = Y + (size_t)en[ai][m] * D;
#pragma unroll
                    for (int bj = 0; bj < 2; ++bj) { const f32x4 v0 = acc[ai][bj][m][0], v1 = acc[ai][bj][m][1];
                        u32x4 w; w.x = cvt_pk_bf16(v0[0], v0[1]); w.y = cvt_pk_bf16(v0[2], v0[3]); w.z = cvt_pk_bf16(v1[0], v1[1]); w.w = cvt_pk_bf16(v1[2], v1[3]);
                        *(u32x4*)(rowp + bj * 128) = w; } } }
    }
};
__device__ __forceinline__ float bflo(unsigned w) { return __uint_as_float(w << 16); }
__device__ __forceinline__ float bfhi(unsigned w) { return __uint_as_float(w & 0xffff0000u); }
struct JobPle : JobBase {
    static constexpr int K = 1024; static constexpr bool PERM = true;
    struct Unit { int pm, pn; };
    int l; const bf16_t* hs; bf16_t* hd; const float* rr; float* ss; LAS float* red;
    __device__ __forceinline__ bool next(int i, Unit& u) const { return g8::dense_unit(i, G, c, T / 256, 4, u.pm, u.pn); }
    __device__ __forceinline__ const char* a_base(const Unit& u) const { return (const char*)hs + (size_t)u.pm * 256 * D * 2; }
    __device__ __forceinline__ const char* b_base(const Unit& u) const { return (const char*)(P.ws + WS_W + WW_PLEG) + ((size_t)l * D + (size_t)u.pn * 256) * D * 2; }
    __device__ __forceinline__ void a_offs(const Unit&, int tid, unsigned (&o)[2][2]) const { dense_offs(D, tid, o); }
    __device__ __forceinline__ void epi(const f32x4 (&acc)[2][2][4][2], const Unit& u, int wr, int wc, int fr, int fq) const {
        const bf16_t* Ub = (const bf16_t*)(P.ws + WS_U) + (size_t)l * T * D;
        const int row0 = u.pm * 256 + wr * 64 + fr, col0 = u.pn * 256 + wc * 32 + 8 * fq;
#pragma unroll
        for (int ai = 0; ai < 2; ++ai) {
            u32x4 hv[4][2], uv[4][2]; float rv[4];
#pragma unroll
            for (int m = 0; m < 4; ++m) { const int row = row0 + ai * 128 + m * 16; const size_t ro = (size_t)row * D + col0; rv[m] = rr[row];
#pragma unroll
                for (int bj = 0; bj < 2; ++bj) { hv[m][bj] = *(const u32x4*)(hs + ro + bj * 128); uv[m][bj] = *(const u32x4*)(Ub + ro + bj * 128); } }
#pragma unroll
            for (int m = 0; m < 4; ++m) { const int row = row0 + ai * 128 + m * 16; const size_t ro = (size_t)row * D + col0; const float r = rv[m]; float s2 = 0.f;
#pragma unroll
                for (int bj = 0; bj < 2; ++bj) { const u32x4 h = hv[m][bj], uu = uv[m][bj]; const f32x4 g0 = acc[ai][bj][m][0] * r, g1 = acc[ai][bj][m][1] * r; float o[8];
                    o[0] = bflo(h.x) + fast_sigmoid(g0[0]) * bflo(uu.x); o[1] = bfhi(h.x) + fast_sigmoid(g0[1]) * bfhi(uu.x);
                    o[2] = bflo(h.y) + fast_sigmoid(g0[2]) * bflo(uu.y); o[3] = bfhi(h.y) + fast_sigmoid(g0[3]) * bfhi(uu.y);
                    o[4] = bflo(h.z) + fast_sigmoid(g1[0]) * bflo(uu.z); o[5] = bfhi(h.z) + fast_sigmoid(g1[1]) * bfhi(uu.z);
                    o[6] = bflo(h.w) + fast_sigmoid(g1[2]) * bflo(uu.w); o[7] = bfhi(h.w) + fast_sigmoid(g1[3]) * bfhi(uu.w);
                    u32x4 w; w.x = cvt_pk_bf16(o[0], o[1]); w.y = cvt_pk_bf16(o[2], o[3]); w.z = cvt_pk_bf16(o[4], o[5]); w.w = cvt_pk_bf16(o[6], o[7]);
                    *(u32x4*)(hd + ro + bj * 128) = w;
                    const float q0 = bflo(w.x), q1 = bfhi(w.x), q2 = bflo(w.y), q3 = bfhi(w.y), q4 = bflo(w.z), q5 = bfhi(w.z), q6 = bflo(w.w), q7 = bfhi(w.w);
                    s2 += ((q0 * q0 + q1 * q1) + (q2 * q2 + q3 * q3)) + ((q4 * q4 + q5 * q5) + (q6 * q6 + q7 * q7)); }
                s2 += __shfl_xor(s2, 16); s2 += __shfl_xor(s2, 32); if (fq == 0) red[(ai * 128 + wr * 64 + m * 16 + fr) * 4 + wc] = s2; }
        }
        asm volatile("s_waitcnt lgkmcnt(0)" ::: "memory"); __builtin_amdgcn_s_barrier(); asm volatile("" ::: "memory");
        { const int t = threadIdx.x; if (t < 256) { const f32x4 p4 = *(const LAS f32x4*)(red + 4 * t); ss[(size_t)(u.pm * 256 + t) * 4 + u.pn] = (p4[0] + p4[1]) + (p4[2] + p4[3]); } }
        asm volatile("s_waitcnt lgkmcnt(0)" ::: "memory"); __builtin_amdgcn_s_barrier(); asm volatile("" ::: "memory");
    }
};
struct JobKvq : JobBase {
    static constexpr int K = 1024; static constexpr bool PERM = true;
    struct Unit { int pm, pn; };
    const bf16_t* hb3; const float* ss3;
    __device__ __forceinline__ bool next(int i, Unit& u) const { return g8::dense_unit(i, G, c, T / 256, 6, u.pm, u.pn); }
    __device__ __forceinline__ const char* a_base(const Unit& u) const { return (const char*)hb3 + (size_t)u.pm * 256 * D * 2; }
    __device__ __forceinline__ const char* b_base(const Unit& u) const { return (const char*)(P.ws + WS_W + WW_KVQ) + (size_t)u.pn * 256 * D * 2; }
    __device__ __forceinline__ void a_offs(const Unit&, int tid, unsigned (&o)[2][2]) const { dense_offs(D, tid, o); }
    __device__ __forceinline__ void epi(const f32x4 (&acc)[2][2][4][2], const Unit& u, int wr, int wc, int fr, int fq) const {
        const float* cs = (const float*)(P.ws + WS_CS);
        const int row0 = u.pm * 256 + wr * 64 + fr, cw = wc * 32 + 8 * fq;
        bf16_t* dst; int ldd; float sc = 1.f;
        if (u.pn == 0) { dst = (bf16_t*)(P.ws + WS_K); ldd = KD; } else if (u.pn == 1) { dst = (bf16_t*)(P.ws + WS_V); ldd = KD; } else { dst = (bf16_t*)(P.ws + WS_Q) + (u.pn - 2) * 256; ldd = D; sc = QSCALE; }
        const bool rope = (u.pn != 1);
        float rv[2][4];
        { f32x4 pv[2][4];
#pragma unroll
          for (int ai = 0; ai < 2; ++ai)
#pragma unroll
            for (int m = 0; m < 4; ++m) pv[ai][m] = *(const f32x4*)(ss3 + (size_t)(row0 + ai * 128 + m * 16) * 4);
#pragma unroll
          for (int ai = 0; ai < 2; ++ai)
#pragma unroll
            for (int m = 0; m < 4; ++m) rv[ai][m] = (pv[ai][m][0] + pv[ai][m][1]) + (pv[ai][m][2] + pv[ai][m][3]); }
#pragma unroll
        for (int ai = 0; ai < 2; ++ai)
#pragma unroll
            for (int mp = 0; mp < 2; ++mp) {
                f32x4 cv[2][2][2];
                if (rope) {
#pragma unroll
                    for (int mm = 0; mm < 2; ++mm) { const int row = row0 + ai * 128 + (2 * mp + mm) * 16;
#pragma unroll
                        for (int bj = 0; bj < 2; ++bj) { const int pi = ((bj * 128 + cw) & 63) >> 1; cv[mm][bj][0] = *(const f32x4*)(cs + (size_t)row * 64 + pi * 2); cv[mm][bj][1] = *(const f32x4*)(cs + (size_t)row * 64 + pi * 2 + 4); } }
                }
#pragma unroll
                for (int mm = 0; mm < 2; ++mm) { const int m = 2 * mp + mm; const int row = row0 + ai * 128 + m * 16; const float r = __builtin_amdgcn_rsqf(rv[ai][m] * (1.f / D) + EPS) * sc;
#pragma unroll
                    for (int bj = 0; bj < 2; ++bj) { f32x4 v0 = acc[ai][bj][m][0] * r, v1 = acc[ai][bj][m][1] * r; const int cc = bj * 128 + cw;
                        if (rope) { const f32x4 c0 = cv[mm][bj][0], c1 = cv[mm][bj][1];
                            f32x4 w0, w1;
                            w0[0] = v0[0] * c0[0] - v0[1] * c0[1]; w0[1] = v0[1] * c0[0] + v0[0] * c0[1]; w0[2] = v0[2] * c0[2] - v0[3] * c0[3]; w0[3] = v0[3] * c0[2] + v0[2] * c0[3];
                            w1[0] = v1[0] * c1[0] - v1[1] * c1[1]; w1[1] = v1[1] * c1[0] + v1[0] * c1[1]; w1[2] = v1[2] * c1[2] - v1[3] * c1[3]; w1[3] = v1[3] * c1[2] + v1[2] * c1[3];
                            v0 = w0; v1 = w1; }
                        u32x4 w; w.x = cvt_pk_bf16(v0[0], v0[1]); w.y = cvt_pk_bf16(v0[2], v0[3]); w.z = cvt_pk_bf16(v1[0], v1[1]); w.w = cvt_pk_bf16(v1[2], v1[3]);
                        *(u32x4*)(dst + (size_t)row * ldd + cc) = w; } }
            }
    }
};
struct JobOproj : JobBase {
    static constexpr int K = 1024; static constexpr bool PERM = true;
    struct Unit { int pm, pn; };
    const bf16_t* hs; bf16_t* hd;
    __device__ __forceinline__ bool next(int i, Unit& u) const { return g8::dense_unit(i, G, c, T / 256, 4, u.pm, u.pn); }
    __device__ __forceinline__ const char* a_base(const Unit& u) const { return (const char*)(P.ws + WS_O) + (size_t)u.pm * 256 * D * 2; }
    __device__ __forceinline__ const char* b_base(const Unit& u) const { return (const char*)(P.ws + WS_W + WW_WO) + (size_t)u.pn * 256 * D * 2; }
    __device__ __forceinline__ void a_offs(const Unit&, int tid, unsigned (&o)[2][2]) const { dense_offs(D, tid, o); }
    __device__ __forceinline__ void epi(const f32x4 (&acc)[2][2][4][2], const Unit& u, int wr, int wc, int fr, int fq) const {
        const int row0 = u.pm * 256 + wr * 64 + fr, col0 = u.pn * 256 + wc * 32 + 8 * fq;
        u32x4 hv[2][4][2];
#pragma unroll
        for (int ai = 0; ai < 2; ++ai)
#pragma unroll
            for (int m = 0; m < 4; ++m) { const size_t ro = (size_t)(row0 + ai * 128 + m * 16) * D + col0;
#pragma unroll
                for (int bj = 0; bj < 2; ++bj) hv[ai][m][bj] = *(const u32x4*)(hs + ro + bj * 128); }
#pragma unroll
        for (int ai = 0; ai < 2; ++ai)
#pragma unroll
            for (int m = 0; m < 4; ++m) { const size_t ro = (size_t)(row0 + ai * 128 + m * 16) * D + col0;
#pragma unroll
                for (int bj = 0; bj < 2; ++bj) { const u32x4 h = hv[ai][m][bj]; const f32x4 a0 = acc[ai][bj][m][0], a1 = acc[ai][bj][m][1];
                    u32x4 w; w.x = cvt_pk_bf16(bflo(h.x) + a0[0], bfhi(h.x) + a0[1]); w.y = cvt_pk_bf16(bflo(h.y) + a0[2], bfhi(h.y) + a0[3]);
                    w.z = cvt_pk_bf16(bflo(h.z) + a1[0], bfhi(h.z) + a1[1]); w.w = cvt_pk_bf16(bflo(h.w) + a1[2], bfhi(h.w) + a1[3]);
                    *(u32x4*)(hd + ro + bj * 128) = w; } }
    }
};
__device__ __forceinline__ int tr_row(int mode, int roff, int n) {
    if (mode == 1) return roff + (n & ~63) + 2 * (n & 31) + ((n >> 5) & 1);
    if (mode == 2) return roff + (n >> 7) * 256 + (n & 127);
    return roff + n;
}
struct TrDesc { const float* W; int N; const float* ksc; const float* nsc; bf16_t* WT; int ldk, mode, roff, k0, n0; };
__device__ __forceinline__ void tr_load(const TrDesc& d, int lane, f32x4 (&v)[8]) {
    const int o = lane >> 3, q = lane & 7; const float* src = d.W + (size_t)(d.k0 + 8 * o) * d.N + d.n0 + 4 * q;
#pragma unroll
    for (int i = 0; i < 8; ++i) v[i] = __builtin_nontemporal_load((const f32x4*)(src + (size_t)i * d.N));
}
__device__ __forceinline__ void tr_store(const TrDesc& d, int lane, const f32x4 (&v)[8]) {
    const int o = lane >> 3, q = lane & 7;
    f32x4 k0v = (f32x4){1.f, 1.f, 1.f, 1.f}, k1v = k0v, nsv = k0v;
    if (d.ksc) { k0v = *(const f32x4*)(d.ksc + d.k0 + 8 * o); k1v = *(const f32x4*)(d.ksc + d.k0 + 8 * o + 4); }
    if (d.nsc) nsv = *(const f32x4*)(d.nsc + d.n0 + 4 * q);
#pragma unroll
    for (int j = 0; j < 4; ++j) { const float ns = nsv[j];
        u32x4 w; w.x = cvt_pk_bf16(v[0][j] * k0v[0] * ns, v[1][j] * k0v[1] * ns); w.y = cvt_pk_bf16(v[2][j] * k0v[2] * ns, v[3][j] * k0v[3] * ns);
        w.z = cvt_pk_bf16(v[4][j] * k1v[0] * ns, v[5][j] * k1v[1] * ns); w.w = cvt_pk_bf16(v[6][j] * k1v[2] * ns, v[7][j] * k1v[3] * ns);
        *(u32x4*)(d.WT + (size_t)tr_row(d.mode, d.roff, d.n0 + 4 * q + j) * d.ldk + d.k0 + 8 * o) = w; }
}
constexpr int N_TR_EXP = 64 * 768, N_TR_SMALL = 2688, N_TR_ITEMS = N_TR_EXP + N_TR_SMALL, N_TR_L0 = 32 * 768, N_TR_PRO = N_TR_L0 + N_TR_SMALL;
__device__ __forceinline__ TrDesc tr_desc(const Ptrs& P, int it) {
    bf16_t* Wb = (bf16_t*)(P.ws + WS_W); TrDesc d;
    if (it < N_TR_EXP) {
        const int le = it / 768, r = it % 768, which = r >> 8, r2 = r & 255, l = le >> 5;
        if (which < 2) d = TrDesc{(which ? P.w_eu : P.w_eg) + (size_t)le * D * DE, DE, P.g_ffn + l * D, nullptr, Wb + WW_GU / 2 + (size_t)le * 1024 * 1024, 1024, 2, which * 128, (r2 >> 4) * 64, (r2 & 15) * 32};
        else d = TrDesc{P.w_ed + (size_t)le * DE * D, D, nullptr, nullptr, Wb + WW_DN / 2 + (size_t)le * 1024 * DE, DE, 0, 0, (r2 >> 5) * 64, (r2 & 31) * 32};
        return d;
    }
    int s = it - N_TR_EXP;
    if (s < 1024) { const int l = s >> 9, r = s & 511; return TrDesc{P.w_pg + (size_t)l * D * D, D, P.g_ple + l * D, nullptr, Wb + WW_PLEG / 2 + (size_t)l * D * D, D, 0, 0, (r >> 5) * 64, (r & 31) * 32}; }
    s -= 1024;
    if (s < 256) { const int l = s >> 7, r = s & 127; return TrDesc{P.w_pu + (size_t)l * PD * D, D, nullptr, nullptr, Wb + WW_PLEU / 2 + (size_t)l * D * PD, PD, 0, 0, (r >> 5) * 64, (r & 31) * 32}; }
    s -= 256;
    if (s < 128) return TrDesc{P.w_k, KD, P.g_kv, nullptr, Wb + WW_KVQ / 2, D, 1, 0, (s >> 3) * 64, (s & 7) * 32};
    s -= 128;
    if (s < 128) return TrDesc{P.w_v, KD, P.g_kv, nullptr, Wb + WW_KVQ / 2, D, 0, 256, (s >> 3) * 64, (s & 7) * 32};
    s -= 128;
    if (s < 512) return TrDesc{P.w_q, D, P.g_mix + D, nullptr, Wb + WW_KVQ / 2, D, 1, 512, (s >> 5) * 64, (s & 31) * 32};
    s -= 512;
    if (s < 512) return TrDesc{P.w_o, D, nullptr, nullptr, Wb + WW_WO / 2, D, 0, 0, (s >> 5) * 64, (s & 31) * 32};
    s -= 512;
    { const int g = s >> 5, r = s & 31; return TrDesc{P.pool_w + (size_t)g * 65536, 256, nullptr, P.pool_scale + g * 256, Wb + WW_POOL / 2 + (size_t)g * 65536, 256, 0, 0, (r >> 3) * 64, (r & 7) * 32}; }
}
__device__ __forceinline__ void filler_slice(int c, int G, int& lo, int& hi) {
    const int q1 = G / 4, q2 = G / 2; const int shares = (c < q1) ? 0 : (c < q2 ? 1 : 2); const int pre = (c < q1) ? 0 : (c < q2 ? (c - q1) : (q2 - q1) + 2 * (c - q2));
    const int tot = (q2 - q1) + 2 * (G - q2); int per = (N_TR_L0 + tot - 1) / tot; per = (per + 1) & ~1;
    lo = per * pre; hi = lo + per * shares; if (lo > N_TR_L0) lo = N_TR_L0; if (hi > N_TR_L0) hi = N_TR_L0;
    if (c == G - 1) hi = N_TR_L0;
}
__device__ __forceinline__ void filler(const Ptrs& P, int lo, int hi, int& fk, unsigned* arrive, int G, int wave, int lane) {
    for (;;) {
        const int it = lo + 2 * wave + 16 * fk;
        if (it >= hi) break;
        if (arrive && (unsigned)__builtin_amdgcn_readfirstlane(__hip_atomic_load(arrive, __ATOMIC_RELAXED, __HIP_MEMORY_SCOPE_AGENT)) >= (unsigned)G) break;
        const bool has2 = it + 1 < hi;
        const TrDesc d0 = tr_desc(P, N_TR_L0 + it), d1 = tr_desc(P, N_TR_L0 + (has2 ? it + 1 : it));
        f32x4 v0[8], v1[8];
        tr_load(d0, lane, v0); tr_load(d1, lane, v1);
        tr_store(d0, lane, v0); if (has2) tr_store(d1, lane, v1);
        ++fk;
    }
}
template <int W> __device__ __forceinline__ void pooldiff_cols(const Ptrs& P, int t0, int s0, const LAS float* rr, int c) {
    const float2 g = *(const float2*)(P.g_mix + c);
    float2 ring[16];
#pragma unroll
    for (int i = 0; i < 16; ++i) ring[i] = make_float2(0.f, 0.f);
    bf16_t* dout = (bf16_t*)(P.ws + WS_D16);
    for (int blk = 0; blk < 5; ++blk) {
#pragma unroll
        for (int jj = 0; jj < 16; ++jj) {
            const int j = blk * 16 + jj - 16;
            const int s = s0 + j;
            float2 v = make_float2(0.f, 0.f);
            if (s >= 0) { const float2 xv = *(const float2*)(P.x + (size_t)(t0 + j) * D + c); const float r = rr[j + 16]; v.x = xv.x * r * g.x; v.y = xv.y * r * g.y; }
            ring[jj] = v;
            if (j >= 0) {
                float2 sum = make_float2(0.f, 0.f);
#pragma unroll
                for (int q = 0; q < W; ++q) { const float2 e = ring[(jj - q) & 15]; sum.x += e.x; sum.y += e.y; }
                const int cnt = (s + 1 < W) ? s + 1 : W; const float ic = 1.f / (float)cnt;
                *(unsigned*)(dout + (size_t)(t0 + j) * D + c) = cvt_pk_bf16(sum.x * ic - v.x, sum.y * ic - v.y);
            }
        }
    }
}
__device__ __forceinline__ void phase_prologue(const Ptrs& P, LAS unsigned char* lds, int vcu, int G) {
    const int tid = threadIdx.x, lane = tid & 63, wave = tid >> 6;
    const int gw = vcu * NWAVES + wave, NGW = G * NWAVES;
    for (int it0 = gw; it0 < N_TR_PRO; it0 += 2 * NGW) {
        const int it20 = it0 + NGW; const bool has2 = it20 < N_TR_PRO;
        const int it = it0 < N_TR_L0 ? it0 : it0 + N_TR_L0, it2 = it20 < N_TR_L0 ? it20 : it20 + N_TR_L0;
        const TrDesc d0 = tr_desc(P, it), d1 = tr_desc(P, has2 ? it2 : it);
        f32x4 v0[8], v1[8];
        tr_load(d0, lane, v0); tr_load(d1, lane, v1);
        tr_store(d0, lane, v0); if (has2) tr_store(d1, lane, v1);
    }
    const size_t gt = (size_t)blockIdx.x * NTHREADS + tid, GT = (size_t)G * NTHREADS;
    { float* wr = (float*)(P.ws + WS_W + WW_WR);
      for (size_t i = gt; i < (size_t)2 * 48 * D; i += GT) { const int k = (int)(i & 1023), n = (int)((i >> 10) % 48), l = (int)(i / (48 * 1024));
          float v = 0.f; if (n < 32) v = P.w_er[((size_t)l * D + k) * 32 + n]; else if (n < 36) v = P.w_gr[((size_t)l * D + k) * 4 + (n - 32)];
          wr[i] = v * P.g_ffn[l * D + k]; } }
    { float2* cs = (float2*)(P.ws + WS_CS);
      for (size_t i = gt; i < (size_t)T * 32; i += GT) { const int t = (int)(i >> 5), j = (int)(i & 31);
          const float inv = exp2f(-(float)j * (13.287712379549449f / 32.f));
          const float ang = (float)P.pos[t] * inv; const double rev = (double)ang * 0.15915494309189535; const float fr = (float)(rev - rint(rev));
          cs[i] = make_float2(__builtin_amdgcn_cosf(fr), __builtin_amdgcn_sinf(fr)); } }
    { bf16_t* p16 = (bf16_t*)(P.ws + WS_P16);
      for (size_t i = gt; i < (size_t)2 * T * PD / 4; i += GT) { const f32x4 v = *(const f32x4*)(P.p + 4 * i); u32x2 w; w.x = cvt_pk_bf16(v[0], v[1]); w.y = cvt_pk_bf16(v[2], v[3]); *(u32x2*)(p16 + 4 * i) = w; } }
    __syncthreads();
    LAS float* rr = (LAS float*)lds;
    for (int ch = blockIdx.x; ch < T / 64; ch += G) {
        const int t0 = ch * 64, s0 = t0 & (SEQ - 1);
        for (int j = wave; j < 80; j += NWAVES) { const int s = s0 + j - 16; float r = 0.f;
            if (s >= 0) { const f32x4* xr = (const f32x4*)(P.x + (size_t)(t0 + j - 16) * D) + lane; float a = 0.f;
#pragma unroll
                for (int q = 0; q < 4; ++q) { const f32x4 v = xr[64 * q]; a += (v[0] * v[0] + v[1] * v[1]) + (v[2] * v[2] + v[3] * v[3]); }
                r = __builtin_amdgcn_rsqf(wave_sum(a) * (1.f / D) + EPS); }
            if (lane == 0) rr[j] = r; }
        __syncthreads();
        const int c = 2 * tid;
        switch (wave >> 1) { case 0: pooldiff_cols<2>(P, t0, s0, rr, c); break; case 1: pooldiff_cols<4>(P, t0, s0, rr, c); break; case 2: pooldiff_cols<8>(P, t0, s0, rr, c); break; default: pooldiff_cols<16>(P, t0, s0, rr, c); break; }
        __syncthreads();
    }
}

typedef float mf4 __attribute__((ext_vector_type(4)));
__device__ __forceinline__ void phase_router(const Ptrs& P, int l, const bf16_t* hs, unsigned* gcnt, unsigned* list, float* rout, LAS unsigned char* lds, int G) {
    const int tid = threadIdx.x, lane = tid & 63, wave = __builtin_amdgcn_readfirstlane(tid >> 6), tg = wave & 3, kh = wave >> 2, li = lane & 15, q = lane >> 4;
    LAS float* bbuf = (LAS float*)lds; LAS float* part = (LAS float*)(lds + 53248); LAS float* ssp = (LAS float*)(lds + 79872);
    LAS unsigned* lcnt = (LAS unsigned*)(lds + 80384); LAS unsigned* lbase = (LAS unsigned*)(lds + 80512);
    const float* wrT = (const float*)(P.ws + WS_W + WW_WR) + (size_t)l * 48 * D;
    float* gwv = rout + T;
    for (int item = blockIdx.x; item < T / 64; item += G) {
        const int row = item * 64 + tg * 16 + li;
        const bf16_t* hrow = hs + (size_t)row * D + kh * 512;
        if (tid < 32) lcnt[tid] = 0u;
        mf4 acc[3];
#pragma unroll
        for (int i = 0; i < 3; ++i) acc[i] = (mf4){0.f, 0.f, 0.f, 0.f};
        float ss = 0.f;
        f32x4 breg[3]; u32x4 areg[2];
#pragma unroll
        for (int j = 0; j < 3; ++j) { const int f = tid + 512 * j, hh = f / 768, rem = f % 768, n = rem >> 4, c4 = rem & 15; breg[j] = *(const f32x4*)(wrT + (size_t)n * D + hh * 512 + c4 * 4); }
#pragma unroll
        for (int c = 0; c < 2; ++c) areg[c] = *(const u32x4*)(hrow + c * 32 + 8 * q);
#pragma unroll
        for (int j = 0; j < 3; ++j) { const int f = tid + 512 * j, hh = f / 768, rem = f % 768, n = rem >> 4, c4 = rem & 15; *(LAS f32x4*)(bbuf + ((hh * 48 + n) * 68 + c4 * 4)) = breg[j]; }
        __syncthreads();
        for (int ch = 0; ch < 8; ++ch) {
            u32x4 acur[2];
#pragma unroll
            for (int c = 0; c < 2; ++c) acur[c] = areg[c];
            if (ch + 1 < 8) {
#pragma unroll
                for (int j = 0; j < 3; ++j) { const int f = tid + 512 * j, hh = f / 768, rem = f % 768, n = rem >> 4, c4 = rem & 15; breg[j] = *(const f32x4*)(wrT + (size_t)n * D + hh * 512 + (ch + 1) * 64 + c4 * 4); }
#pragma unroll
                for (int c = 0; c < 2; ++c) areg[c] = *(const u32x4*)(hrow + (ch + 1) * 64 + c * 32 + 8 * q);
            }
            const LAS float* bb = bbuf + (ch & 1) * (2 * 48 * 68) + kh * 48 * 68;
#pragma unroll
            for (int c = 0; c < 2; ++c) {
                const u32x4 aw = acur[c];
                float a[8]; a[0] = bflo(aw.x); a[1] = bfhi(aw.x); a[2] = bflo(aw.y); a[3] = bfhi(aw.y); a[4] = bflo(aw.z); a[5] = bfhi(aw.z); a[6] = bflo(aw.w); a[7] = bfhi(aw.w);
#pragma unroll
                for (int hf = 0; hf < 2; ++hf)
#pragma unroll
                    for (int ntile = 0; ntile < 3; ++ntile) { const f32x4 b = *(const LAS f32x4*)(bb + (ntile * 16 + li) * 68 + c * 32 + 8 * q + 4 * hf);
#pragma unroll
                        for (int s = 0; s < 4; ++s) acc[ntile] = __builtin_amdgcn_mfma_f32_16x16x4f32(a[4 * hf + s], b[s], acc[ntile], 0, 0, 0); }
#pragma unroll
                for (int j = 0; j < 8; ++j) ss += a[j] * a[j];
            }
            if (ch + 1 < 8) {
#pragma unroll
                for (int j = 0; j < 3; ++j) { const int f = tid + 512 * j, hh = f / 768, rem = f % 768, n = rem >> 4, c4 = rem & 15; *(LAS f32x4*)(bbuf + ((ch + 1) & 1) * (2 * 48 * 68) + ((hh * 48 + n) * 68 + c4 * 4)) = breg[j]; }
            }
            __syncthreads();
        }
        ss += __shfl_xor(ss, 16); ss += __shfl_xor(ss, 32);
        if (q == 0) ssp[kh * 64 + tg * 16 + li] = ss;
#pragma unroll
        for (int ntile = 0; ntile < 3; ++ntile)
#pragma unroll
            for (int rg = 0; rg < 4; ++rg) part[(kh * 64 + tg * 16 + 4 * q + rg) * 49 + ntile * 16 + li] = acc[ntile][rg];
        __syncthreads();
        int ea = 0, eb = 0; unsigned pa = 0, pb = 0; const int t = item * 64 + tid;
        if (tid < 64) {
            const float r = __builtin_amdgcn_rsqf((ssp[tid] + ssp[64 + tid]) * (1.f / D) + EPS);
            float lg[36];
#pragma unroll
            for (int j = 0; j < 36; ++j) lg[j] = (part[tid * 49 + j] + part[(64 + tid) * 49 + j]) * r;
            float gl[4]; int gs = 0; float gm = -1e30f;
#pragma unroll
            for (int j = 0; j < 4; ++j) { gl[j] = lg[32 + j] + P.b_gr[l * 4 + j]; if (gl[j] > gm) { gm = gl[j]; gs = j; } }
            float gsum = 0.f;
#pragma unroll
            for (int j = 0; j < 4; ++j) gsum += __expf(gl[j] - gm);
            const float pg = 1.f / gsum;
            float el[8];
#pragma unroll
            for (int j = 0; j < 8; ++j) { float v = 0.f;
#pragma unroll
                for (int g = 0; g < 4; ++g) v = (g == gs) ? lg[g * 8 + j] : v;
                el[j] = v + P.b_er[l * 32 + gs * 8 + j]; }
            int i0 = 0; float v0 = el[0];
#pragma unroll
            for (int j = 1; j < 8; ++j) if (el[j] > v0) { v0 = el[j]; i0 = j; }
            int i1 = -1; float v1 = -1e30f;
#pragma unroll
            for (int j = 0; j < 8; ++j) if (j != i0 && el[j] > v1) { v1 = el[j]; i1 = j; }
            const float e1 = __expf(v1 - v0); const float g0 = pg / (1.f + e1), g1 = pg * e1 / (1.f + e1);
            rout[t] = r; gwv[2 * t] = g0; gwv[2 * t + 1] = g1;
            ea = gs * 8 + i0; eb = gs * 8 + i1;
            pa = __hip_atomic_fetch_add(&lcnt[ea], 1u, __ATOMIC_RELAXED, __HIP_MEMORY_SCOPE_WORKGROUP); pb = __hip_atomic_fetch_add(&lcnt[eb], 1u, __ATOMIC_RELAXED, __HIP_MEMORY_SCOPE_WORKGROUP);
        }
        __syncthreads();
        if (tid < 32) { const unsigned n = lcnt[tid]; lbase[tid] = n ? atomicAdd(&gcnt[tid], n) : 0u; }
        __syncthreads();
        if (tid < 64) { list[(size_t)ea * T + lbase[ea] + pa] = 2u * t; list[(size_t)eb * T + lbase[eb] + pb] = 2u * t + 1u; }
        __syncthreads();
    }
}

__device__ __forceinline__ void unpack8(const u32x4 w, float (&o)[8]) { o[0] = bflo(w.x); o[1] = bfhi(w.x); o[2] = bflo(w.y); o[3] = bfhi(w.y); o[4] = bflo(w.z); o[5] = bfhi(w.z); o[6] = bflo(w.w); o[7] = bfhi(w.w); }
__device__ __forceinline__ void phase_combine(const Ptrs& P, const bf16_t* hs, bf16_t* hd, float* rr, int vcu, int G) {
    const int lane = threadIdx.x & 63, gw = vcu * NWAVES + (threadIdx.x >> 6), NGW = G * NWAVES;
    for (int row = gw; row < T; row += NGW) {
        const u32x4* h = (const u32x4*)(hs + (size_t)row * D) + lane; const u32x4* y = (const u32x4*)((const bf16_t*)(P.ws + WS_Y) + (size_t)row * 2 * D) + lane;
        u32x4 hw[2], y0[2], y1[2];
#pragma unroll
        for (int j = 0; j < 2; ++j) { hw[j] = h[64 * j]; y0[j] = y[64 * j]; y1[j] = y[128 + 64 * j]; }
        u32x4 ow[2]; float s = 0.f;
#pragma unroll
        for (int j = 0; j < 2; ++j) { float a[8], b[8], c[8]; unpack8(hw[j], a); unpack8(y0[j], b); unpack8(y1[j], c);
#pragma unroll
            for (int e = 0; e < 8; ++e) a[e] += b[e] + c[e];
            ow[j].x = cvt_pk_bf16(a[0], a[1]); ow[j].y = cvt_pk_bf16(a[2], a[3]); ow[j].z = cvt_pk_bf16(a[4], a[5]); ow[j].w = cvt_pk_bf16(a[6], a[7]);
            float qv[8]; unpack8(ow[j], qv);
#pragma unroll
            for (int e = 0; e < 8; ++e) s += qv[e] * qv[e]; }
        const float r = __builtin_amdgcn_rsqf(wave_sum(s) * (1.f / D) + EPS);
        u32x4* o = (u32x4*)(hd + (size_t)row * D) + lane;
#pragma unroll
        for (int j = 0; j < 2; ++j) o[64 * j] = ow[j];
        if (lane == 0) rr[row] = r;
    }
}
__device__ __forceinline__ void phase_final(const Ptrs& P, const bf16_t* hs, const float* ss, float* outp, int vcu, int G) {
    const int lane = threadIdx.x & 63, gw = vcu * NWAVES + (threadIdx.x >> 6), NGW = G * NWAVES;
    f32x4 gf[2][2];
#pragma unroll
    for (int j = 0; j < 2; ++j) { gf[j][0] = *((const f32x4*)(P.g_final + 512 * j + 8 * lane)); gf[j][1] = *((const f32x4*)(P.g_final + 512 * j + 8 * lane + 4)); }
    for (int row = gw; row < T; row += NGW) {
        const u32x4* h = (const u32x4*)(hs + (size_t)row * D) + lane; const f32x4 pv = *(const f32x4*)(ss + (size_t)row * 4); const float sq = (pv[0] + pv[1]) + (pv[2] + pv[3]);
        const float r = __builtin_amdgcn_rsqf(sq * (1.f / D) + EPS);
        float* o = outp + (size_t)row * D + 8 * lane;
#pragma unroll
        for (int j = 0; j < 2; ++j) { float a[8]; unpack8(h[64 * j], a);
            f32x4 o0, o1; o0[0] = a[0] * r * gf[j][0][0]; o0[1] = a[1] * r * gf[j][0][1]; o0[2] = a[2] * r * gf[j][0][2]; o0[3] = a[3] * r * gf[j][0][3];
            o1[0] = a[4] * r * gf[j][1][0]; o1[1] = a[5] * r * gf[j][1][1]; o1[2] = a[6] * r * gf[j][1][2]; o1[3] = a[7] * r * gf[j][1][3];
            __builtin_nontemporal_store(o0, (f32x4*)(o + 512 * j)); __builtin_nontemporal_store(o1, (f32x4*)(o + 512 * j + 4)); }
    }
}
constexpr int AT_KSTR = 144, AT_VSTR = 520, AT_VOFF = 256 * AT_KSTR;
__device__ __forceinline__ int crow16(int reg, int h) { return (reg & 3) + 8 * (reg >> 2) + 4 * h; }
__device__ __forceinline__ void phase_attn(const Ptrs& P, LAS unsigned char* lds, int G) {
    const int tid = threadIdx.x, lane = tid & 63, wave = __builtin_amdgcn_readfirstlane(tid >> 6), r32 = lane & 31, hh = lane >> 5;
    const bf16_t* Qb = (const bf16_t*)(P.ws + WS_Q); const bf16_t* Kb = (const bf16_t*)(P.ws + WS_K); const bf16_t* Vb = (const bf16_t*)(P.ws + WS_V); bf16_t* Ob = (bf16_t*)(P.ws + WS_O);
    for (int unit = blockIdx.x; unit < 2 * 64 * 4; unit += G) {
        const int kh = unit & 3, nb = (unit >> 2) & 63, b = unit >> 8;
        const int tq0 = b * SEQ + nb * 128;
        __syncthreads();
        {
            const int key = tid >> 1, hf = tid & 1; const bool ok = (nb > 0) || (key >= 128);
            u32x4 kv[4], vv[4];
#pragma unroll
            for (int i = 0; i < 4; ++i) { kv[i] = (u32x4){0u, 0u, 0u, 0u}; vv[i] = (u32x4){0u, 0u, 0u, 0u}; }
            if (ok) { const size_t go = (size_t)(tq0 - 128 + key) * KD + kh * 64 + hf * 32;
#pragma unroll
                for (int i = 0; i < 4; ++i) { kv[i] = *(const u32x4*)(Kb + go + 8 * i); vv[i] = *(const u32x4*)(Vb + go + 8 * i); } }
#pragma unroll
            for (int i = 0; i < 4; ++i) *(LAS u32x4*)(lds + key * AT_KSTR + hf * 64 + 16 * i) = kv[i];
#pragma unroll
            for (int i = 0; i < 4; ++i)
#pragma unroll
                for (int e = 0; e < 4; ++e) { const unsigned w = vv[i][e]; const int d = hf * 32 + 8 * i + 2 * e;
                    *(LAS bf16_t*)(lds + AT_VOFF + d * AT_VSTR + key * 2) = (bf16_t)(w & 0xffffu); *(LAS bf16_t*)(lds + AT_VOFF + (d + 1) * AT_VSTR + key * 2) = (bf16_t)(w >> 16); }
        }
        __syncthreads();
        const int g = wave >> 1, head = kh * 4 + g; const float sink = P.sinks[head] * LOG2E;
        for (int qq = 0; qq < 2; ++qq) {
            const int qi = (wave & 1) * 2 + qq;
            const int tq = tq0 + qi * 32 + r32;
            bf16x8 qf[4];
#pragma unroll
            for (int s = 0; s < 4; ++s) qf[s] = *(const bf16x8*)(Qb + (size_t)tq * D + head * 64 + 16 * s + 8 * hh);
            f32x16 st[5];
#pragma unroll
            for (int kt = 0; kt < 5; ++kt) {
                f32x16 a;
#pragma unroll
                for (int i = 0; i < 16; ++i) a[i] = 0.f;
                const LAS unsigned char* kp = lds + (32 * (qi + kt) + r32) * AT_KSTR + 16 * hh;
#pragma unroll
                for (int s = 0; s < 4; ++s) { const bf16x8 kf = *(const LAS bf16x8*)(kp + 32 * s); a = __builtin_amdgcn_mfma_f32_32x32x16_bf16(kf, qf[s], a, 0, 0, 0); }
                st[kt] = a;
            }
            const int iq = qi * 32 + r32;
            float mx = sink;
#pragma unroll
            for (int kt = 0; kt < 5; ++kt)
#pragma unroll
                for (int i = 0; i < 16; ++i) { const int jb = 32 * (qi + kt) + crow16(i, hh); const bool valid = (jb > iq) && (jb <= iq + 128) && (nb > 0 || jb >= 128);
                    const float v = valid ? st[kt][i] : -1e30f; st[kt][i] = v; mx = fmaxf(mx, v); }
            mx = fmaxf(mx, __shfl_xor(mx, 32));
            float sum = 0.f;
#pragma unroll
            for (int kt = 0; kt < 5; ++kt)
#pragma unroll
                for (int i = 0; i < 16; ++i) { const float e = __builtin_amdgcn_exp2f(st[kt][i] - mx); st[kt][i] = e; sum += e; }
            sum += __shfl_xor(sum, 32);
            const float inv = 1.f / (sum + __builtin_amdgcn_exp2f(sink - mx));
            f32x16 o0, o1;
#pragma unroll
            for (int i = 0; i < 16; ++i) { o0[i] = 0.f; o1[i] = 0.f; }
#pragma unroll
            for (int kt = 0; kt < 5; ++kt)
#pragma unroll
                for (int s = 0; s < 2; ++s) {
                    u32x4 pw; pw.x = cvt_pk_bf16(st[kt][8 * s + 0], st[kt][8 * s + 1]); pw.y = cvt_pk_bf16(st[kt][8 * s + 2], st[kt][8 * s + 3]);
                    pw.z = cvt_pk_bf16(st[kt][8 * s + 4], st[kt][8 * s + 5]); pw.w = cvt_pk_bf16(st[kt][8 * s + 6], st[kt][8 * s + 7]);
                    const bf16x8 pf = __builtin_bit_cast(bf16x8, pw);
                    const int key0 = 32 * (qi + kt) + 16 * s + 4 * hh;
                    const LAS unsigned char* vp0 = lds + AT_VOFF + r32 * AT_VSTR + key0 * 2; const LAS unsigned char* vp1 = vp0 + 32 * AT_VSTR;
                    const s16x4 a00 = *(const LAS s16x4*)(vp0), a01 = *(const LAS s16x4*)(vp0 + 16), a10 = *(const LAS s16x4*)(vp1), a11 = *(const LAS s16x4*)(vp1 + 16);
                    const bf16x8 v0 = __builtin_shufflevector(a00, a01, 0, 1, 2, 3, 4, 5, 6, 7), v1 = __builtin_shufflevector(a10, a11, 0, 1, 2, 3, 4, 5, 6, 7);
                    o0 = __builtin_amdgcn_mfma_f32_32x32x16_bf16(v0, pf, o0, 0, 0, 0);
                    o1 = __builtin_amdgcn_mfma_f32_32x32x16_bf16(v1, pf, o1, 0, 0, 0);
                }
            bf16_t* op = Ob + (size_t)tq * D + head * 64 + 4 * hh;
#pragma unroll
            for (int gq = 0; gq < 4; ++gq) {
                u32x2 w0, w1; w0.x = cvt_pk_bf16(o0[4 * gq] * inv, o0[4 * gq + 1] * inv); w0.y = cvt_pk_bf16(o0[4 * gq + 2] * inv, o0[4 * gq + 3] * inv);
                w1.x = cvt_pk_bf16(o1[4 * gq] * inv, o1[4 * gq + 1] * inv); w1.y = cvt_pk_bf16(o1[4 * gq + 2] * inv, o1[4 * gq + 3] * inv);
                *(u32x2*)(op + 8 * gq) = w0; *(u32x2*)(op + 32 + 8 * gq) = w1;
            }
        }
    }
}

constexpr int NPHASE = 16;
struct Args { Ptrs P; int ph_lo, ph_hi; };
__global__ void __launch_bounds__(NTHREADS, 2) yoco_fwd(Args args) {
    extern __shared__ __attribute__((aligned(16))) unsigned char lds_raw[];
    LAS unsigned char* lds = (LAS unsigned char*)lds_raw;
    const Ptrs& P = args.P;
    const int tid = threadIdx.x, G = gridDim.x, bx = blockIdx.x;
    const int vcu = (G % 8 == 0) ? (bx % 8) * (G / 8) + bx / 8 : bx;
    volatile LAS unsigned* MISC = (volatile LAS unsigned*)(lds + MISC_OFF);
    if (tid < 4) MISC[tid] = 0u;
    __syncthreads();
    const int lo = args.ph_lo, hi = args.ph_hi;
    const bool multi = (hi - lo) > 1;
    XcdBarrier bar; bar.bar = (unsigned*)(P.ws + WS_CTL) + CW_BAR; bar.x = 0; bar.st = MISC;
    if (multi) bar = xcd_barrier_post((unsigned*)(P.ws + WS_CTL) + CW_BAR, MISC);
    bf16_t* HBA = (bf16_t*)(P.ws + WS_HBA); bf16_t* HBB = (bf16_t*)(P.ws + WS_HBB);
    LAS int* tt = (LAS int*)(lds + TT_OFF);
    unsigned* const CTLW = (unsigned*)(P.ws + WS_CTL);
    int f_lo, f_hi, fk = 0; filler_slice(bx, G, f_lo, f_hi);
#ifdef ONLY_PH
#define IN(k) ((k) == ONLY_PH)
#else
#define IN(k) (lo <= (k) && (k) < hi)
#endif
#ifndef FILL_WMASK
#define FILL_WMASK 0
#endif
#ifndef FILL_MASK
#define FILL_MASK 0x98u
#endif
#define SEAM(k) do { if (IN(k) && IN((k) + 1)) { \
        if ((FILL_MASK >> (k)) & 1u) { __syncthreads(); if (tid == 0) __hip_atomic_fetch_add(CTLW + CW_ARR + 64 * (k), 1u, __ATOMIC_RELAXED, __HIP_MEMORY_SCOPE_AGENT); \
            if (((tid >> 6) & FILL_WMASK) == 0) filler(P, f_lo, f_hi, fk, CTLW + CW_ARR + 64 * (k), G, __builtin_amdgcn_readfirstlane(tid >> 6), tid & 63); } \
        if ((k) == 10) filler(P, f_lo, f_hi, fk, nullptr, G, __builtin_amdgcn_readfirstlane(tid >> 6), tid & 63); \
        xcd_barrier(bar); } } while (0)
#ifndef REPEAT_MASK
#define REPEAT_MASK 0u
#endif
#define REP(k) if ((REPEAT_MASK >> (k)) & 1u)
    float* const DRYH = (float*)(P.ws + 448 * MiB); bf16_t* const DRYB = (bf16_t*)(P.ws + 448 * MiB);
    unsigned* const CNT0 = (unsigned*)(P.ws + WS_CTL) + CW_CNT; unsigned* const LIST = (unsigned*)(P.ws + WS_LIST);
    float* const ROUT = (float*)(P.ws + WS_RX) + T; float* const R2 = (float*)(P.ws + WS_RX) + 4 * T;
    float* const SS3 = (float*)(P.ws + WS_END); float* const SS6 = SS3 + 4 * T; float* const SSD = (float*)DRYH + 48 * T;
    bf16_t* const HsA = HBA; bf16_t* const HsB = HBB;
#define JB(J) J.P = P; J.G = G; J.c = bx
    if (IN(0)) { phase_prologue(P, lds, vcu, G); REP(0) { xcd_barrier(bar); phase_prologue(P, lds, vcu, G); } } SEAM(0);
    if (IN(1)) {
        REP(1) { { JobPool J; JB(J); J.hs = HsA; g8::gemm_phase(lds, J); } { JobUp J; JB(J); g8::gemm_phase(lds, J); } xcd_barrier(bar); }
        { JobPool J; JB(J); J.hs = HsA; g8::gemm_phase(lds, J); }
        { JobUp J; JB(J); g8::gemm_phase(lds, J); }
    } SEAM(1);
    if (IN(2)) { phase_router(P, 0, HsA, CNT0, LIST, ROUT, lds, G); REP(2) { xcd_barrier(bar); phase_router(P, 0, HsA, CNT0 + 128, (unsigned*)DRYH, (float*)DRYH + 32 * T, lds, G); } } SEAM(2);
    if (IN(3)) { build_tile_table(P, 0, tt); REP(3) { JobGateUp J; JB(J); J.l = 0; J.hb = HsA; J.tt = tt; J.rr = ROUT; g8::gemm_phase(lds, J); xcd_barrier(bar); }
                 JobGateUp J; JB(J); J.l = 0; J.hb = HsA; J.tt = tt; J.rr = ROUT; g8::gemm_phase(lds, J); } SEAM(3);
    if (IN(4)) { build_tile_table(P, 0, tt); REP(4) { JobDown J; JB(J); J.l = 0; J.tt = tt; g8::gemm_phase(lds, J); xcd_barrier(bar); }
                 JobDown J; JB(J); J.l = 0; J.tt = tt; g8::gemm_phase(lds, J); } SEAM(4);
    if (IN(5)) { REP(5) { phase_combine(P, HsA, DRYB, (float*)DRYH + 16 * T * 64, vcu, G); xcd_barrier(bar); } phase_combine(P, HsA, HsA, R2, vcu, G); } SEAM(5);
    if (IN(6)) { REP(6) { JobPle J; JB(J); J.l = 0; J.hs = HsA; J.hd = DRYB; J.rr = R2; J.ss = SSD; J.red = (LAS float*)(lds + RED_OFF); g8::gemm_phase(lds, J); xcd_barrier(bar); }
                 JobPle J; JB(J); J.l = 0; J.hs = HsA; J.hd = HsB; J.rr = R2; J.ss = SS3; J.red = (LAS float*)(lds + RED_OFF); g8::gemm_phase(lds, J); } SEAM(6);
    if (IN(7)) { REP(7) { JobKvq J; JB(J); J.hb3 = HsB; J.ss3 = SS3; g8::gemm_phase(lds, J); xcd_barrier(bar); }
                 JobKvq J; JB(J); J.hb3 = HsB; J.ss3 = SS3; g8::gemm_phase(lds, J); } SEAM(7);
    if (IN(8)) { REP(8) { phase_attn(P, lds, G); __syncthreads(); xcd_barrier(bar); } phase_attn(P, lds, G); __syncthreads(); } SEAM(8);
    if (IN(9)) { REP(9) { JobOproj J; JB(J); J.hs = HsB; J.hd = DRYB; g8::gemm_phase(lds, J); xcd_barrier(bar); }
                 JobOproj J; JB(J); J.hs = HsB; J.hd = HsB; g8::gemm_phase(lds, J); } SEAM(9);
    if (IN(10)) { phase_router(P, 1, HsB, CNT0 + 64, LIST, ROUT, lds, G); REP(10) { xcd_barrier(bar); phase_router(P, 1, HsB, CNT0 + 192, (unsigned*)DRYH, (float*)DRYH + 32 * T, lds, G); } } SEAM(10);
    if (IN(11)) { build_tile_table(P, 1, tt); REP(11) { JobGateUp J; JB(J); J.l = 1; J.hb = HsB; J.tt = tt; J.rr = ROUT; g8::gemm_phase(lds, J); xcd_barrier(bar); }
                  JobGateUp J; JB(J); J.l = 1; J.hb = HsB; J.tt = tt; J.rr = ROUT; g8::gemm_phase(lds, J); } SEAM(11);
    if (IN(12)) { build_tile_table(P, 1, tt); REP(12) { JobDown J; JB(J); J.l = 1; J.tt = tt; g8::gemm_phase(lds, J); xcd_barrier(bar); }
                  JobDown J; JB(J); J.l = 1; J.tt = tt; g8::gemm_phase(lds, J); } SEAM(12);
    if (IN(13)) { REP(13) { phase_combine(P, HsB, DRYB, (float*)DRYH + 16 * T * 64, vcu, G); xcd_barrier(bar); } phase_combine(P, HsB, HsB, R2, vcu, G); } SEAM(13);
    if (IN(14)) { REP(14) { JobPle J; JB(J); J.l = 1; J.hs = HsB; J.hd = DRYB; J.rr = R2; J.ss = SSD; J.red = (LAS float*)(lds + RED_OFF); g8::gemm_phase(lds, J); xcd_barrier(bar); }
                  JobPle J; JB(J); J.l = 1; J.hs = HsB; J.hd = HsA; J.rr = R2; J.ss = SS6; J.red = (LAS float*)(lds + RED_OFF); g8::gemm_phase(lds, J); } SEAM(14);
    if (IN(15)) { REP(15) { phase_final(P, HsA, SS6, DRYH, vcu, G); xcd_barrier(bar); } phase_final(P, HsA, SS6, P.out, vcu, G); }
#undef JB
#undef IN
#undef SEAM
}
#ifndef HYBRID
#define HYBRID 0
#endif
#ifndef NAIVE_MASK
#define NAIVE_MASK 0u
#endif
extern "C" void kernel_launch(void* const* d_in, const int* in_sizes, int n_in, void* d_out, int out_size, void* d_ws, size_t ws_size, hipStream_t stream) {
    static int grid = 0;
    if (grid == 0) {
        if (n_in != 24 || in_sizes[0] != T * D || out_size != T * D || ws_size < WS_END) { fprintf(stderr, "kernel_launch: unexpected problem (n_in %d, ws %zu)\n", n_in, ws_size); grid = -1; return; }
        int dev = 0, cus = 0, per_cu = 0;
        if (hipGetDevice(&dev) != hipSuccess || hipDeviceGetAttribute(&cus, hipDeviceAttributeMultiprocessorCount, dev) != hipSuccess) { grid = -1; return; }
        if (hipFuncSetAttribute((const void*)yoco_fwd, hipFuncAttributeMaxDynamicSharedMemorySize, LDS_BYTES) != hipSuccess) { fprintf(stderr, "kernel_launch: hipFuncSetAttribute failed\n"); grid = -1; return; }
        if (hipOccupancyMaxActiveBlocksPerMultiprocessor(&per_cu, (const void*)yoco_fwd, NTHREADS, LDS_BYTES) != hipSuccess || per_cu < 1) { fprintf(stderr, "kernel_launch: occupancy query says %d\n", per_cu); }
        (void)hipGetLastError();
        grid = cus;
    }
    if (grid < 0) return;
    Ptrs P; memset(&P, 0, sizeof P);
    P.x = (const float*)d_in[0]; P.p = (const float*)d_in[1]; P.pos = (const int*)d_in[2]; P.g_mix = (const float*)d_in[3]; P.g_ffn = (const float*)d_in[4];
    P.pool_w = (const float*)d_in[5]; P.pool_scale = (const float*)d_in[6]; P.g_kv = (const float*)d_in[7]; P.w_k = (const float*)d_in[8]; P.w_v = (const float*)d_in[9];
    P.w_q = (const float*)d_in[10]; P.w_o = (const float*)d_in[11]; P.sinks = (const float*)d_in[12]; P.w_gr = (const float*)d_in[13]; P.b_gr = (const float*)d_in[14];
    P.w_er = (const float*)d_in[15]; P.b_er = (const float*)d_in[16]; P.w_eg = (const float*)d_in[17]; P.w_eu = (const float*)d_in[18]; P.w_ed = (const float*)d_in[19];
    P.g_ple = (const float*)d_in[20]; P.w_pg = (const float*)d_in[21]; P.w_pu = (const float*)d_in[22]; P.g_final = (const float*)d_in[23];
    P.out = (float*)d_out; P.ws = (unsigned char*)d_ws;
    (void)hipMemsetAsync(P.ws + WS_CTL, 0, 1 * MiB, stream);
    Args a; memset(&a, 0, sizeof a); a.P = P;
    a.ph_lo = 0; a.ph_hi = NPHASE;
    hipLaunchKernelGGL(yoco_fwd, dim3(grid), dim3(NTHREADS), LDS_BYTES, stream, a);
}
```
